# Optimizing an MI355X kernel written in HIP

```python
import math
import jax, jax.numpy as jnp
from jax import lax
import numpy as np

D_MODEL = 1024
BATCH = 16
SEQ = 4096
DEPTH = 1
DEC_BATCH = 8
DEC_SEQ = 2048
PAST_LEN = 128

PLE_DIM = 256
ATTN_WIDTH = D_MODEL // 2
LRU_WIDTH = D_MODEL - ATTN_WIDTH
N_HEADS = 8
HEAD_V = ATTN_WIDTH // N_HEADS
HEAD_QK = HEAD_V // 2
ATTN_SCALE = HEAD_QK ** -0.5
Q_BLOCK = 128
N_BUCKETS = 32
MAX_DIST = 128
LRU_BLOCKS = 8
LRU_BW = LRU_WIDTH // LRU_BLOCKS
LRU_C = 8.0
CONV_W = 4
CONV_LEFT = 2
IN_COLS = 4 * ATTN_WIDTH + 2 * LRU_WIDTH
EPS = 1e-6

kernel_name = "hybrid_diffattn_rglru_encoder"


def rms_norm(x, g):
    xf = x.astype(jnp.float32)
    y = xf * lax.rsqrt(jnp.mean(xf * xf, axis=-1, keepdims=True) + EPS)
    return (y * g.astype(jnp.float32)).astype(x.dtype)


def t5_bucket(rel):
    half = N_BUCKETS // 2
    max_exact = half // 2
    ret = jnp.where(rel > 0, half, 0)
    n = jnp.abs(rel)
    nf = jnp.maximum(n, 1).astype(jnp.float32)
    large = max_exact + (jnp.log(nf / max_exact) / math.log(MAX_DIST / max_exact)
                         * (half - max_exact)).astype(jnp.int32)
    large = jnp.minimum(large, half - 1)
    return ret + jnp.where(n < max_exact, n, large)


def diff_attention(q, k, v, q_norm, k_norm, lam, sub_norm, lam_init, rel_bias):
    B, S = q.shape[0], q.shape[1]
    qf = rms_norm(q, q_norm).astype(jnp.float32) * ATTN_SCALE
    kf = rms_norm(k, k_norm).astype(jnp.float32)
    vf = v.astype(jnp.float32)
    nb = S // Q_BLOCK
    qb = qf.reshape(B, nb, Q_BLOCK, N_HEADS, 2, HEAD_QK).transpose(1, 0, 2, 3, 4, 5)
    kpos = jnp.arange(S, dtype=jnp.int32)
    tbl = rel_bias.astype(jnp.float32)

    def one_block(args):
        qblk, j = args
        qpos = j * Q_BLOCK + jnp.arange(Q_BLOCK, dtype=jnp.int32)
        bias = tbl[t5_bucket(kpos[None, :] - qpos[:, None])]
        bias = jnp.transpose(bias, (2, 0, 1))
        s = jnp.einsum('bqhcd,bkhcd->bhcqk', qblk, kf) + bias[None, :, None]
        pr = jax.nn.softmax(s, axis=-1)
        w = pr[:, :, 0] - lam * pr[:, :, 1]
        return jnp.einsum('bhqk,bkhe->bqhe', w, vf)

    o = lax.map(one_block, (qb, jnp.arange(nb, dtype=jnp.int32)))
    o = o.transpose(1, 0, 2, 3, 4).reshape(B, S, N_HEADS, HEAD_V)
    o = rms_norm(o, sub_norm) * (1.0 - lam_init)
    return o.reshape(B, S, ATTN_WIDTH).astype(q.dtype)


def _lin_combine(c1, c2):
    a1, b1 = c1
    a2, b2 = c2
    return a1 * a2, a2 * b1 + b2


def rg_lru_branch(x, conv_w, conv_b, w_a, b_a, w_x, b_x, lru_lambda):
    B, S, W = x.shape
    xf = x.astype(jnp.float32)
    xp = jnp.pad(xf, ((0, 0), (CONV_LEFT, CONV_W - 1 - CONV_LEFT), (0, 0)))
    cw = conv_w.astype(jnp.float32)
    y = conv_b.astype(jnp.float32) + sum(xp[:, t:t + S] * cw[t] for t in range(CONV_W))
    yb = y.reshape(B, S, LRU_BLOCKS, LRU_BW)
    out = jnp.zeros_like(y)
    for d in range(2):
        r = jax.nn.sigmoid(jnp.einsum('bsni,nij->bsnj', yb, w_a[d].astype(jnp.float32)).reshape(B, S, W)
                           + b_a[d].astype(jnp.float32))
        i = jax.nn.sigmoid(jnp.einsum('bsni,nij->bsnj', yb, w_x[d].astype(jnp.float32)).reshape(B, S, W)
                           + b_x[d].astype(jnp.float32))
        log_a = -LRU_C * r * jax.nn.softplus(-lru_lambda[d].astype(jnp.float32))
        a = jnp.exp(log_a)
        bterm = jnp.sqrt(-jnp.expm1(2.0 * log_a)) * (i * y)
        _, hs = lax.associative_scan(_lin_combine, (a, bterm), reverse=(d == 1), axis=1)
        out = out + hs
    return out.astype(x.dtype)


def run_trunk(x, p, g_norm, w_in, q_norm, k_norm, lam_q1, lam_k1, lam_q2, lam_k2, sub_norm,
              rel_bias, conv_w, conv_b, w_a, b_a, w_x, b_x, lru_lambda, w_out, w_ple, w_pg, g_ple):
    B, S, _ = x.shape
    h = x
    for l in range(DEPTH):
        lam_init = 0.8 - 0.6 * math.exp(-0.3 * l)
        u = rms_norm(h, g_norm[l])
        z = jnp.einsum('bsd,dc->bsc', u, w_in[l])
        A = ATTN_WIDTH
        q = z[..., 0:A].reshape(B, S, N_HEADS, 2, HEAD_QK)
        k = z[..., A:2 * A].reshape(B, S, N_HEADS, 2, HEAD_QK)
        v = z[..., 2 * A:3 * A].reshape(B, S, N_HEADS, HEAD_V)
        g_att = z[..., 3 * A:4 * A]
        xr = z[..., 4 * A:4 * A + LRU_WIDTH]
        g_lru = z[..., 4 * A + LRU_WIDTH:]
        lam = (jnp.exp(jnp.sum(lam_q1[l].astype(jnp.float32) * lam_k1[l].astype(jnp.float32)))
               - jnp.exp(jnp.sum(lam_q2[l].astype(jnp.float32) * lam_k2[l].astype(jnp.float32)))
               + lam_init)
        o_att = diff_attention(q, k, v, q_norm[l], k_norm[l], lam, sub_norm[l], lam_init, rel_bias)
        o_lru = rg_lru_branch(xr, conv_w[l], conv_b[l], w_a[l], b_a[l], w_x[l], b_x[l], lru_lambda[l])
        mix = jnp.concatenate([o_att * jax.nn.silu(g_att), o_lru * jax.nn.silu(g_lru)], axis=-1)
        h = h + jnp.einsum('bsc,cd->bsd', mix, w_out[l])
        e = jnp.einsum('bsp,pd->bsd', p[l], w_ple[l]) * jax.nn.sigmoid(
            jnp.einsum('bsd,de->bse', h, w_pg[l]))
        h = h + rms_norm(e, g_ple[l])
    return h


def setup_inputs(seed: int = 0) -> dict:
    key = jax.random.key(seed)
    ks = jax.random.split(key, 32)
    f32 = jnp.float32
    nrm = lambda k, s, sc: jax.random.normal(k, s, f32) * sc
    a0 = jax.random.uniform(ks[20], (DEPTH, 2, LRU_WIDTH), f32, 0.9, 0.999)
    s0 = a0 ** (1.0 / LRU_C)
    lru_lambda = jnp.log(s0) - jnp.log1p(-s0)
    return {
        "x_prompt": nrm(ks[0], (BATCH, SEQ, D_MODEL), 1.0),
        "x_sample": nrm(ks[1], (DEC_BATCH, DEC_SEQ, D_MODEL), 1.0),
        "p_prompt": nrm(ks[2], (DEPTH, BATCH, SEQ, PLE_DIM), 1.0),
        "p_sample": nrm(ks[3], (DEPTH, DEC_BATCH, DEC_SEQ, PLE_DIM), 1.0),
        "g_norm": 1.0 + nrm(ks[4], (DEPTH, D_MODEL), 0.02),
        "w_in": nrm(ks[5], (DEPTH, D_MODEL, IN_COLS), D_MODEL ** -0.5),
        "q_norm": 1.0 + nrm(ks[6], (DEPTH, HEAD_QK), 0.02),
        "k_norm": 1.0 + nrm(ks[7], (DEPTH, HEAD_QK), 0.02),
        "lam_q1": nrm(ks[8], (DEPTH, HEAD_QK), 0.1),
        "lam_k1": nrm(ks[9], (DEPTH, HEAD_QK), 0.1),
        "lam_q2": nrm(ks[10], (DEPTH, HEAD_QK), 0.1),
        "lam_k2": nrm(ks[11], (DEPTH, HEAD_QK), 0.1),
        "sub_norm": 1.0 + nrm(ks[12], (DEPTH, HEAD_V), 0.02),
        "rel_bias": nrm(ks[13], (N_BUCKETS, N_HEADS), 0.5),
        "conv_w": nrm(ks[14], (DEPTH, CONV_W, LRU_WIDTH), CONV_W ** -0.5),
        "conv_b": nrm(ks[15], (DEPTH, LRU_WIDTH), 0.01),
        "w_a": nrm(ks[16], (DEPTH, 2, LRU_BLOCKS, LRU_BW, LRU_BW), LRU_BW ** -0.5),
        "b_a": nrm(ks[17], (DEPTH, 2, LRU_WIDTH), 0.1),
        "w_x": nrm(ks[18], (DEPTH, 2, LRU_BLOCKS, LRU_BW, LRU_BW), LRU_BW ** -0.5),
        "b_x": nrm(ks[19], (DEPTH, 2, LRU_WIDTH), 0.1),
        "lru_lambda": lru_lambda,
        "w_out": nrm(ks[21], (DEPTH, ATTN_WIDTH + LRU_WIDTH, D_MODEL), (ATTN_WIDTH + LRU_WIDTH) ** -0.5),
        "w_ple": nrm(ks[22], (DEPTH, PLE_DIM, D_MODEL), PLE_DIM ** -0.5),
        "w_pg": nrm(ks[23], (DEPTH, D_MODEL, D_MODEL), D_MODEL ** -0.5),
        "g_ple": 1.0 + nrm(ks[24], (DEPTH, D_MODEL), 0.02),
    }


def reference(x_prompt, x_sample, p_prompt, p_sample, g_norm, w_in, q_norm, k_norm,
              lam_q1, lam_k1, lam_q2, lam_k2, sub_norm, rel_bias, conv_w, conv_b,
              w_a, b_a, w_x, b_x, lru_lambda, w_out, w_ple, w_pg, g_ple):
    y_prompt = run_trunk(x_prompt, p_prompt, g_norm, w_in, q_norm, k_norm, lam_q1, lam_k1,
                         lam_q2, lam_k2, sub_norm, rel_bias, conv_w, conv_b, w_a, b_a, w_x,
                         b_x, lru_lambda, w_out, w_ple, w_pg, g_ple)
    y_sample = run_trunk(x_sample, p_sample, g_norm, w_in, q_norm, k_norm, lam_q1, lam_k1,
                         lam_q2, lam_k2, sub_norm, rel_bias, conv_w, conv_b, w_a, b_a, w_x,
                         b_x, lru_lambda, w_out, w_ple, w_pg, g_ple)
    return (y_prompt, y_sample)
```

```cpp
#include <hip/hip_runtime.h>
#include <cstdint>
#include <cstdio>
namespace pg8 {
#define PG8_LAS __attribute__((address_space(3)))
typedef unsigned short bf16_t;
typedef short bf16x8 __attribute__((ext_vector_type(8)));
typedef float f32x4 __attribute__((ext_vector_type(4)));
typedef unsigned u32x4 __attribute__((ext_vector_type(4)));
constexpr int BM = 256, BK = 64, HALF = 128, HTB = HALF * BK * 2  , STAGE_BYTES = 8 * HTB, NXCD = 8, WGM = 8;

__host__ __device__ __forceinline__ int lds_byte(int r, int c) { const int st = (r >> 4) * 2 + (c >> 5), rr = r & 15, cc = c & 31, ob = rr * 64 + cc * 2; return st * 1024 + (ob ^ (((ob >> 9) & 1) << 5)); }
__host__ __device__ __forceinline__ void stage_rc(int b, int& R, int& C) { const int st = b / 1024, sb = b % 1024, swz = sb ^ (((sb >> 9) & 1) << 5); R = (st >> 1) * 16 + swz / 64; C = (st & 1) * 32 + (swz % 64) / 2; }
__host__ __device__ __forceinline__ int perm32(int rho) { const int n = rho >> 4, i = rho & 15; return 8 * (i >> 2) + 4 * n + (i & 3); }

struct Unit { int pm, pn; };
struct Gemm { const bf16_t* A; const bf16_t* Bt; int M, N, K; };

struct StaticOrder {
    int nM, nN, nwg, G, c;
    __host__ __device__ void init(int M, int N, int G_, int c_) { nM = M / BM; nN = N / BM; nwg = nM * nN; G = G_; c = c_; }
    __host__ __device__ bool next(int i, Unit& u) const {
        const long L = (long)i * G + c; if (L >= nwg) return false;
        int wgid = (int)L; { const int q = nwg / NXCD, r = nwg % NXCD, xcd = wgid % NXCD, off = wgid / NXCD; wgid = (xcd < r ? xcd * (q + 1) : r * (q + 1) + (xcd - r) * q) + off; }
        const int nig = WGM * nN, gid = wgid / nig, fm = gid * WGM, gsz = (nM - fm) < WGM ? (nM - fm) : WGM;
        u.pm = fm + ((wgid % nig) % gsz); u.pn = (wgid % nig) / gsz; return true;
    }
    __device__ __forceinline__ void a_ready(const Unit&) const {}
    __device__ __forceinline__ void done(const Unit&) const {}
};

typedef float f32x2 __attribute__((ext_vector_type(2)));
template <class Epi, class Sched, bool ALIGN_EPI = false, bool SP2 = false>
__device__ __forceinline__ void gemm_phase(PG8_LAS unsigned char* lds, const Gemm g, const Sched& S, const Epi& E) {
    int tid_ = threadIdx.x; asm volatile("" : "+v"(tid_));
    const int tid = tid_, wid = __builtin_amdgcn_readfirstlane(tid >> 6), lane = tid & 63, wr = wid >> 2, wc = wid & 3, fr = lane & 15, fq = lane >> 4;
    int K_ = g.K; asm volatile("" : "+s"(K_));
    const int K = K_, nt = K / BK;
    unsigned voffA[2], voffB[2];
#pragma unroll
    for (int i = 0; i < 2; ++i) { int R, C; stage_rc(tid * 16 + i * 8192, R, C); const int Rb = Epi::PERM ? ((R & ~31) + perm32(R & 31)) : R;
        voffA[i] = (unsigned)(R * K + C) * 2u; voffB[i] = (unsigned)(Rb * K + C) * 2u; }
    const size_t kstep = (size_t)(BK * 2);
    const size_t hstep = (size_t)HALF * K * 2;
    const size_t tstep = 2 * hstep;
    const unsigned ldsw = (unsigned)wid * 1024u;
    const int aoff = lds_byte(wr * 64 + fr, fq * 8), boff = lds_byte(wc * 32 + fr, fq * 8);
#define PG8_SA(b, h) (((b) * 2 + (h)) * HTB)
#define PG8_SB(b, h) ((4 + (b) * 2 + (h)) * HTB)
#define PG8_STAGE(bufoff, gbase, voff) do { _Pragma("unroll") for (int _i = 0; _i < 2; ++_i) \
        __builtin_amdgcn_global_load_lds((const unsigned*)((const char*)(gbase) + (voff)[_i]), (PG8_LAS unsigned*)(lds + (bufoff) + ldsw + _i * 8192), 16, 0, 0); } while (0)
#define PG8_LDA(dst, b, h) do { _Pragma("unroll") for (int m = 0; m < 4; ++m) _Pragma("unroll") for (int k = 0; k < 2; ++k) dst[m][k] = *(const PG8_LAS bf16x8*)(lds + PG8_SA(b, h) + aoff + m * 2048 + k * 1024); } while (0)
#define PG8_LDB(dst, b, h) do { _Pragma("unroll") for (int n = 0; n < 2; ++n) _Pragma("unroll") for (int k = 0; k < 2; ++k) dst[n][k] = *(const PG8_LAS bf16x8*)(lds + PG8_SB(b, h) + boff + n * 2048 + k * 1024); } while (0)
#define PG8_MMA(ai, bj, At, Bt) do { __builtin_amdgcn_s_setprio(1); _Pragma("unroll") for (int m = 0; m < 4; ++m) _Pragma("unroll") for (int n = 0; n < 2; ++n) _Pragma("unroll") for (int k = 0; k < 2; ++k) \
        acc[ai][bj][m][n] = __builtin_amdgcn_mfma_f32_16x16x32_bf16(Bt[n][k], At[m][k], acc[ai][bj][m][n], 0, 0, 0); __builtin_amdgcn_s_setprio(0); } while (0)
#define PG8_WAIT_V(n) asm volatile("s_waitcnt vmcnt(" #n ")" ::: "memory")
#define PG8_WAIT_L(n) asm volatile("s_waitcnt lgkmcnt(" #n ")" ::: "memory")
#define PG8_BAR __builtin_amdgcn_s_barrier()
#define PG8_SCHED __builtin_amdgcn_sched_barrier(0)
    Unit cur, nxt; int ui = 0;
    if (!S.next(0, cur)) return;
    f32x4 acc[2][2][4][2];
#pragma unroll
    for (int a = 0; a < 2; ++a)
#pragma unroll
        for (int b = 0; b < 2; ++b)
#pragma unroll
            for (int m = 0; m < 4; ++m)
#pragma unroll
                for (int n = 0; n < 2; ++n) acc[a][b][m][n] = (f32x4){0.f, 0.f, 0.f, 0.f};
    bf16x8 At[4][2], B0[2][2], B1[2][2];
    const char* cA = (const char*)g.A + (size_t)cur.pm * tstep; const char* cB = (const char*)g.Bt + (size_t)cur.pn * tstep;
    S.a_ready(cur);
    if constexpr (SP2) {
        PG8_STAGE(PG8_SB(0, 0), cB, voffB); PG8_STAGE(PG8_SB(0, 1), cB + hstep, voffB); PG8_STAGE(PG8_SA(0, 0), cA, voffA); PG8_STAGE(PG8_SA(0, 1), cA + hstep, voffA);
        if (wr == 1) PG8_BAR;
        PG8_WAIT_V(2); PG8_BAR;
        PG8_STAGE(PG8_SB(1, 0), cB + kstep, voffB); PG8_STAGE(PG8_SA(1, 0), cA + kstep, voffA); PG8_STAGE(PG8_SB(1, 1), cB + hstep + kstep, voffB);
        PG8_WAIT_V(6); PG8_BAR;
    } else {
        PG8_STAGE(PG8_SB(0, 0), cB, voffB); PG8_STAGE(PG8_SA(0, 0), cA, voffA); PG8_STAGE(PG8_SB(0, 1), cB + hstep, voffB); PG8_STAGE(PG8_SA(0, 1), cA + hstep, voffA);
        if (wr == 1) PG8_BAR;
        PG8_WAIT_V(4); PG8_BAR;
        PG8_STAGE(PG8_SB(1, 0), cB + kstep, voffB); PG8_STAGE(PG8_SA(1, 0), cA + kstep, voffA); PG8_STAGE(PG8_SB(1, 1), cB + hstep + kstep, voffB);
        PG8_WAIT_V(6); PG8_BAR;
    }
    for (;;) {
        const bool has_next = S.next(ui + 1, nxt);
        const char* nA = has_next ? (const char*)g.A + (size_t)nxt.pm * tstep : cA; const char* nB = has_next ? (const char*)g.Bt + (size_t)nxt.pn * tstep : cB;
        for (int t = 0; t < nt; t += 2) {
            const bool last = (t == nt - 2);
            const char* a1 = cA + (size_t)(t + 1) * kstep;
            const char* a2 = last ? nA : cA + (size_t)(t + 2) * kstep; const char* b2 = last ? nB : cB + (size_t)(t + 2) * kstep;
            const char* a3 = a2 + kstep; const char* b3 = b2 + kstep;
            if (last && has_next) S.a_ready(nxt);
            if constexpr (SP2) {
            PG8_LDB(B0, 0, 0); PG8_LDB(B1, 0, 1); PG8_SCHED; PG8_LDA(At, 0, 0); PG8_STAGE(PG8_SA(1, 1), a1 + hstep, voffA);
            PG8_WAIT_V(8); PG8_WAIT_L(0); PG8_BAR; PG8_MMA(0, 0, At, B0); PG8_MMA(0, 1, At, B1); PG8_BAR; PG8_SCHED;
            PG8_LDA(At, 0, 1); PG8_STAGE(PG8_SB(0, 0), b2, voffB); PG8_STAGE(PG8_SB(0, 1), b2 + hstep, voffB); PG8_STAGE(PG8_SA(0, 0), a2, voffA);
            PG8_WAIT_V(8); PG8_WAIT_L(0); PG8_BAR; PG8_MMA(1, 0, At, B0); PG8_MMA(1, 1, At, B1); PG8_BAR; PG8_SCHED;
            PG8_LDB(B0, 1, 0); PG8_LDB(B1, 1, 1); PG8_SCHED; PG8_LDA(At, 1, 0); PG8_STAGE(PG8_SA(0, 1), a2 + hstep, voffA);
            PG8_WAIT_V(8); PG8_WAIT_L(0); PG8_BAR; PG8_MMA(0, 0, At, B0); PG8_MMA(0, 1, At, B1); PG8_BAR; PG8_SCHED;
            PG8_LDA(At, 1, 1); PG8_STAGE(PG8_SB(1, 0), b3, voffB); PG8_STAGE(PG8_SB(1, 1), b3 + hstep, voffB); PG8_STAGE(PG8_SA(1, 0), a3, voffA);
            PG8_WAIT_V(8); PG8_WAIT_L(0); PG8_BAR; PG8_MMA(1, 0, At, B0); PG8_MMA(1, 1, At, B1); PG8_BAR; PG8_SCHED;
            } else {
            PG8_LDB(B0, 0, 0); PG8_SCHED; PG8_LDA(At, 0, 0); PG8_STAGE(PG8_SA(1, 1), a1 + hstep, voffA);
            PG8_WAIT_L(8); PG8_BAR; PG8_WAIT_L(0); PG8_MMA(0, 0, At, B0); PG8_BAR; PG8_SCHED;
            PG8_LDB(B1, 0, 1); PG8_STAGE(PG8_SB(0, 0), b2, voffB);
            PG8_BAR; PG8_WAIT_L(0); PG8_MMA(0, 1, At, B1); PG8_BAR;
            PG8_LDA(At, 0, 1); PG8_STAGE(PG8_SA(0, 0), a2, voffA);
            PG8_BAR; PG8_WAIT_L(0); PG8_MMA(1, 0, At, B0); PG8_BAR; PG8_SCHED;
            PG8_STAGE(PG8_SB(0, 1), b2 + hstep, voffB);
            PG8_WAIT_V(6); PG8_BAR; PG8_MMA(1, 1, At, B1); PG8_BAR;
            PG8_LDB(B0, 1, 0); PG8_SCHED; PG8_LDA(At, 1, 0); PG8_STAGE(PG8_SA(0, 1), a2 + hstep, voffA);
            PG8_WAIT_L(8); PG8_BAR; PG8_WAIT_L(0); PG8_MMA(0, 0, At, B0); PG8_BAR; PG8_SCHED;
            PG8_LDB(B1, 1, 1); PG8_STAGE(PG8_SB(1, 0), b3, voffB);
            PG8_BAR; PG8_WAIT_L(0); PG8_MMA(0, 1, At, B1); PG8_BAR;
            PG8_LDA(At, 1, 1); PG8_STAGE(PG8_SA(1, 0), a3, voffA);
            PG8_BAR; PG8_WAIT_L(0); PG8_MMA(1, 0, At, B0); PG8_BAR; PG8_SCHED;
            PG8_STAGE(PG8_SB(1, 1), b3 + hstep, voffB);
            PG8_WAIT_V(6); PG8_BAR; PG8_MMA(1, 1, At, B1); PG8_BAR;
            }
        }
        if constexpr (ALIGN_EPI) { if (wr == 0) PG8_BAR; }
        if constexpr (!Epi::AFTER_DRAIN) { E(acc, cur, wr, wc, fr, fq); S.done(cur); }
        if (!has_next) break;
#pragma unroll
        for (int a = 0; a < 2; ++a)
#pragma unroll
            for (int b = 0; b < 2; ++b)
#pragma unroll
                for (int m = 0; m < 4; ++m)
#pragma unroll
                    for (int n = 0; n < 2; ++n) acc[a][b][m][n] = (f32x4){0.f, 0.f, 0.f, 0.f};
        cur = nxt; cA = nA; cB = nB; ++ui;
        if constexpr (ALIGN_EPI) { if (wr == 1) PG8_BAR; }
    }
    PG8_WAIT_V(0);
    if constexpr (!ALIGN_EPI) { if (wr == 0) PG8_BAR; }
    PG8_BAR;
    if constexpr (Epi::AFTER_DRAIN) { E.fused(acc, cur, wr, wc, fr, fq, lds, wid, lane); S.done(cur); }
#undef PG8_SA
#undef PG8_SB
#undef PG8_STAGE
#undef PG8_LDA
#undef PG8_LDB
#undef PG8_MMA
#undef PG8_WAIT_V
#undef PG8_WAIT_L
#undef PG8_BAR
#undef PG8_SCHED
}
}

using pg8::bf16_t; using pg8::f32x4; using pg8::u32x4; using pg8::Unit;
#define LAS __attribute__((address_space(3)))
constexpr int DM = 1024, NH = 8, PLE = 256, INC = 3072;
constexpr int BP = 16, SP = 4096, BS = 8, SS = 2048;
constexpr int MP = BP * SP, MS = BS * SS, MT = MP + MS;
constexpr float EPS = 1e-6f, LOG2E = 1.4426950408889634f;
constexpr float LAM_INIT = 0.2f;
constexpr int NWAVES = 8, NTHREADS = 512;
constexpr int LDS_BYTES = 147456;

constexpr size_t MiB = 1u << 20;
constexpr size_t WS_CTL = 0, CTL_ZERO_BYTES = 1 * MiB;
constexpr int CW_QUEUE = 1024;
constexpr int CW_PANEL = 32768;
constexpr int CW_PREP = 16384;
constexpr int CW_BAR = 4096;
constexpr int MISC_OFF = LDS_BYTES - 1024;
constexpr size_t WS_WIN = 2 * MiB, WS_WOUT = 8 * MiB, WS_WPG = 10 * MiB, WS_WPLE = 12 * MiB, WS_MISC = 14 * MiB;
constexpr size_t WS_XN = 16 * MiB;
constexpr size_t WS_MIX = WS_XN;
constexpr size_t WS_Q = 176 * MiB, WS_K = 256 * MiB, WS_V = 336 * MiB, WS_GA = 416 * MiB, WS_XR = 496 * MiB, WS_GL = 576 * MiB;
constexpr size_t WS_PB = 656 * MiB;
constexpr size_t WS_HSF = 696 * MiB;
constexpr size_t WS_HSB = 856 * MiB;
constexpr size_t WS_HB = WS_Q;
constexpr size_t WS_PW = WS_XR;
constexpr size_t WS_END = 1016 * MiB;

__device__ __forceinline__ unsigned f2bf(float f) { unsigned u = __builtin_bit_cast(unsigned, f); return (u + 0x7fffu + ((u >> 16) & 1u)) >> 16; }
__device__ __forceinline__ float bf2f(unsigned h) { return __builtin_bit_cast(float, h << 16); }
__device__ __forceinline__ float fast_sigmoid(float x) { return __builtin_amdgcn_rcpf(1.f + __builtin_amdgcn_exp2f(-LOG2E * x)); }
typedef float f32x2_t __attribute__((ext_vector_type(2))); typedef __bf16 bf16x2_t __attribute__((ext_vector_type(2)));
__device__ __forceinline__ unsigned pk2(float lo, float hi) { f32x2_t v = {lo, hi}; bf16x2_t b = __builtin_convertvector(v, bf16x2_t); return __builtin_bit_cast(unsigned, b); }

struct Ptrs {
    const float *xp, *xs, *pp, *ps, *g_norm, *w_in, *q_norm, *k_norm, *lq1, *lk1, *lq2, *lk2, *sub_norm, *rel_bias, *conv_w, *conv_b, *w_a, *b_a, *w_x, *b_x, *lam, *w_out, *w_ple, *w_pg, *g_ple;
    float* out; unsigned char* ws;
};
__device__ __forceinline__ const float* xrow(const Ptrs& P, int m) { return m < MP ? P.xp + (size_t)m * DM : P.xs + (size_t)(m - MP) * DM; }
__device__ __forceinline__ const float* prow(const Ptrs& P, int m) { return m < MP ? P.pp + (size_t)m * PLE : P.ps + (size_t)(m - MP) * PLE; }

struct EpiIn {
    static constexpr bool PERM = true, AFTER_DRAIN = false;
    unsigned char* ws; const float* qn; const float* kn;
    __device__ __forceinline__ void operator()(const f32x4 (&acc)[2][2][4][2], const Unit& u, int wr, int wc, int fr, int fq) const {
        const int t = u.pn >> 1;
        bf16_t* O = (bf16_t*)(ws + WS_Q + (size_t)t * (80 * MiB));
        const int row0 = u.pm * 256 + wr * 64 + fr, col0 = (u.pn & 1) * 256 + wc * 32 + 8 * fq;
        f32x4 g0 = {1.f, 1.f, 1.f, 1.f}, g1 = g0;
        if (t < 2) { const float* gp = (t == 0 ? qn : kn) + 8 * fq; g0 = *(const f32x4*)gp; g1 = *(const f32x4*)(gp + 4); if (t == 0) { g0 = g0 * (0.17677669529663687f * LOG2E); g1 = g1 * (0.17677669529663687f * LOG2E); } }
#pragma unroll
        for (int ai = 0; ai < 2; ++ai)
#pragma unroll
            for (int m = 0; m < 4; ++m) { bf16_t* rowp = O + (size_t)(row0 + ai * 128 + m * 16) * 512 + col0;
#pragma unroll
                for (int bj = 0; bj < 2; ++bj) { f32x4 v0 = acc[ai][bj][m][0], v1 = acc[ai][bj][m][1];
                    if (t < 2) { float ss = (v0[0]*v0[0] + v0[1]*v0[1]) + (v0[2]*v0[2] + v0[3]*v0[3]) + (v1[0]*v1[0] + v1[1]*v1[1]) + (v1[2]*v1[2] + v1[3]*v1[3]);
                        ss += __shfl_xor(ss, 16); ss += __shfl_xor(ss, 32); const float rs = __builtin_amdgcn_rsqf(ss * (1.f / 32.f) + EPS); v0 = v0 * rs * g0; v1 = v1 * rs * g1; }
                    else if (t == 3 || t == 5) {
#pragma unroll
                        for (int j = 0; j < 4; ++j) { v0[j] = v0[j] * fast_sigmoid(v0[j]); v1[j] = v1[j] * fast_sigmoid(v1[j]); } }
                    u32x4 w; w.x = pk2(v0[0], v0[1]); w.y = pk2(v0[2], v0[3]); w.z = pk2(v1[0], v1[1]); w.w = pk2(v1[2], v1[3]);
                    *(u32x4*)(rowp + bj * 128) = w; } }
    }
};
struct EpiOut {
    static constexpr bool PERM = true, AFTER_DRAIN = false;
    const float* xp; const float* xs; float* out; bf16_t* hb;
    __device__ __forceinline__ void operator()(const f32x4 (&acc)[2][2][4][2], const Unit& u, int wr, int wc, int fr, int fq) const {
        const int row0 = u.pm * 256 + wr * 64 + fr, col0 = u.pn * 256 + wc * 32 + 8 * fq;
        const float* xb = (u.pm * 256 < MP) ? xp : xs - (size_t)MP * DM;
#pragma unroll
        for (int ai = 0; ai < 2; ++ai)
#pragma unroll
            for (int m = 0; m < 4; ++m) { const size_t off = (size_t)(row0 + ai * 128 + m * 16) * DM + col0;
#pragma unroll
                for (int bj = 0; bj < 2; ++bj) { const f32x4 x0 = *(const f32x4*)(xb + off + bj * 128), x1 = *(const f32x4*)(xb + off + bj * 128 + 4);
                    const f32x4 v0 = acc[ai][bj][m][0] + x0, v1 = acc[ai][bj][m][1] + x1;
                    u32x4 w; w.x = pk2(v0[0], v0[1]); w.y = pk2(v0[2], v0[3]); w.z = pk2(v1[0], v1[1]); w.w = pk2(v1[2], v1[3]);
                    *(u32x4*)(hb + off + bj * 128) = w; } }
    }
};
struct EpiStore {
    static constexpr bool PERM = true, AFTER_DRAIN = false;
    bf16_t* o;
    __device__ __forceinline__ void operator()(const f32x4 (&acc)[2][2][4][2], const Unit& u, int wr, int wc, int fr, int fq) const {
        const int row0 = u.pm * 256 + wr * 64 + fr, col0 = u.pn * 256 + wc * 32 + 8 * fq;
#pragma unroll
        for (int ai = 0; ai < 2; ++ai)
#pragma unroll
            for (int m = 0; m < 4; ++m) { const size_t off = (size_t)(row0 + ai * 128 + m * 16) * DM + col0;
#pragma unroll
                for (int bj = 0; bj < 2; ++bj) { const f32x4 v0 = acc[ai][bj][m][0], v1 = acc[ai][bj][m][1];
                    u32x4 w; w.x = pk2(v0[0], v0[1]); w.y = pk2(v0[2], v0[3]); w.z = pk2(v1[0], v1[1]); w.w = pk2(v1[2], v1[3]);
                    *(u32x4*)(o + off + bj * 128) = w; } }
    }
};
struct EpiGateFinal {
    static constexpr bool PERM = true, AFTER_DRAIN = false;
    const bf16_t* pw; const bf16_t* hb; float* out; const float* gp; float* slots; unsigned* cnt;
    __device__ __forceinline__ void operator()(f32x4 (&acc)[2][2][4][2], const Unit& u, int wr, int wc, int fr, int fq) const {
        const int row0 = u.pm * 256 + wr * 64 + fr, col0 = u.pn * 256 + wc * 32 + 8 * fq;
        float ss[2][4];
#pragma unroll
        for (int ai = 0; ai < 2; ++ai)
#pragma unroll
            for (int m = 0; m < 4; ++m) { const size_t off = (size_t)(row0 + ai * 128 + m * 16) * DM + col0; float q = 0.f;
#pragma unroll
                for (int bj = 0; bj < 2; ++bj) { const u32x4 s = *(const u32x4*)(pw + off + bj * 128); f32x4 v0 = acc[ai][bj][m][0], v1 = acc[ai][bj][m][1];
#pragma unroll
                    for (int j = 0; j < 4; ++j) { v0[j] = fast_sigmoid(v0[j]); v1[j] = fast_sigmoid(v1[j]); }
                    v0[0] *= bf2f(s.x & 0xffff); v0[1] *= bf2f(s.x >> 16); v0[2] *= bf2f(s.y & 0xffff); v0[3] *= bf2f(s.y >> 16);
                    v1[0] *= bf2f(s.z & 0xffff); v1[1] *= bf2f(s.z >> 16); v1[2] *= bf2f(s.w & 0xffff); v1[3] *= bf2f(s.w >> 16);
                    acc[ai][bj][m][0] = v0; acc[ai][bj][m][1] = v1;
                    q += (v0[0]*v0[0] + v0[1]*v0[1]) + (v0[2]*v0[2] + v0[3]*v0[3]) + (v1[0]*v1[0] + v1[1]*v1[1]) + (v1[2]*v1[2] + v1[3]*v1[3]); }
                q += __shfl_xor(q, 16); q += __shfl_xor(q, 32); ss[ai][m] = q; asm volatile("" ::: "memory"); }
        if (fq == 0) {
#pragma unroll
            for (int ai = 0; ai < 2; ++ai)
#pragma unroll
                for (int m = 0; m < 4; ++m) __hip_atomic_store(slots + (size_t)(row0 + ai * 128 + m * 16) * 16 + u.pn * 4 + wc, ss[ai][m], __ATOMIC_RELAXED, __HIP_MEMORY_SCOPE_AGENT);
        }
        asm volatile("s_waitcnt vmcnt(0)" ::: "memory");
        unsigned* c = cnt + 64 * u.pm;
        if ((threadIdx.x & 63) == 0) __hip_atomic_fetch_add(c, 1u, __ATOMIC_RELAXED, __HIP_MEMORY_SCOPE_AGENT);
        { unsigned sp = 0; while (__hip_atomic_load(c, __ATOMIC_RELAXED, __HIP_MEMORY_SCOPE_AGENT) < 32u) { __builtin_amdgcn_s_sleep(2); if (++sp > (1u << 22)) break; } }
        const f32x4 g00 = *(const f32x4*)(gp + col0), g01 = *(const f32x4*)(gp + col0 + 4), g10 = *(const f32x4*)(gp + col0 + 128), g11 = *(const f32x4*)(gp + col0 + 132);
#pragma unroll
        for (int ai = 0; ai < 2; ++ai)
#pragma unroll
            for (int m = 0; m < 4; ++m) { const size_t row = (size_t)(row0 + ai * 128 + m * 16); const size_t off = row * DM + col0;
                const unsigned long long* sl = (const unsigned long long*)(slots + row * 16 + fq * 4);
                const unsigned long long p0 = __hip_atomic_load(sl, __ATOMIC_RELAXED, __HIP_MEMORY_SCOPE_AGENT), p1 = __hip_atomic_load(sl + 1, __ATOMIC_RELAXED, __HIP_MEMORY_SCOPE_AGENT);
                float t = (__uint_as_float((unsigned)p0) + __uint_as_float((unsigned)(p0 >> 32))) + (__uint_as_float((unsigned)p1) + __uint_as_float((unsigned)(p1 >> 32)));
                t += __shfl_xor(t, 16); t += __shfl_xor(t, 32);
                const float rs = rsqrtf(t * (1.f / DM) + EPS);
#pragma unroll
                for (int bj = 0; bj < 2; ++bj) { const u32x4 hv = *(const u32x4*)(hb + off + bj * 128); const f32x4 ga = bj ? g10 : g00, gb = bj ? g11 : g01; const f32x4 v0 = acc[ai][bj][m][0], v1 = acc[ai][bj][m][1]; f32x4 o0, o1;
                    o0[0] = bf2f(hv.x & 0xffff) + v0[0] * rs * ga[0]; o0[1] = bf2f(hv.x >> 16) + v0[1] * rs * ga[1]; o0[2] = bf2f(hv.y & 0xffff) + v0[2] * rs * ga[2]; o0[3] = bf2f(hv.y >> 16) + v0[3] * rs * ga[3];
                    o1[0] = bf2f(hv.z & 0xffff) + v1[0] * rs * gb[0]; o1[1] = bf2f(hv.z >> 16) + v1[1] * rs * gb[1]; o1[2] = bf2f(hv.w & 0xffff) + v1[2] * rs * gb[2]; o1[3] = bf2f(hv.w >> 16) + v1[3] * rs * gb[3];
                    *(f32x4*)(out + off + bj * 128) = o0; *(f32x4*)(out + off + bj * 128 + 4) = o1; }
                asm volatile("" ::: "memory"); }
    }
};

__device__ __forceinline__ void p0_transpose_item(const float* W, int K, int N, bf16_t* WT, LAS float* scr, int item, int lane) {
    const int nblk = N / 32, kb = item / nblk, nb = item % nblk, k0 = 64 * kb, n0 = 32 * nb;
#pragma unroll 8
    for (int i = 0; i < 32; ++i) { const int kk = 2 * i + (lane >> 5); scr[kk * 33 + (lane & 31)] = W[(size_t)(k0 + kk) * N + n0 + (lane & 31)]; }
    asm volatile("s_waitcnt lgkmcnt(0)" ::: "memory");
    const int c = lane & 7;
#pragma unroll
    for (int j = 0; j < 4; ++j) { const int n = (lane >> 3) + 8 * j; const LAS float* s = scr + (8 * c) * 33 + n;
        u32x4 o; o.x = pk2(s[0 * 33], s[1 * 33]); o.y = pk2(s[2 * 33], s[3 * 33]); o.z = pk2(s[4 * 33], s[5 * 33]); o.w = pk2(s[6 * 33], s[7 * 33]);
        *(u32x4*)(WT + (size_t)(n0 + n) * K + k0 + 8 * c) = o; }
    asm volatile("s_waitcnt lgkmcnt(0)" ::: "memory");
}
__device__ __forceinline__ void prep_signal(unsigned* cnt, int lane) {
    asm volatile("s_waitcnt vmcnt(0)" ::: "memory");
    if (lane == 0) __hip_atomic_fetch_add(cnt, 1u, __ATOMIC_RELAXED, __HIP_MEMORY_SCOPE_AGENT);
}
template <bool SIGNAL> __device__ __forceinline__ void prep_rows64(const Ptrs& P, int rb, int wave, int lane, unsigned* cnt) {
#pragma unroll 1
    for (int k = 0; k < 2; ++k) {
        const int m0 = rb + wave * 8 + 4 * k; f32x4 v[4][4]; float ss[4];
#pragma unroll
        for (int q = 0; q < 4; ++q) { const float* xq = xrow(P, m0 + q);
#pragma unroll
            for (int j = 0; j < 4; ++j) v[q][j] = *(const f32x4*)(xq + j * 256 + lane * 4); }
#pragma unroll
        for (int q = 0; q < 4; ++q) { float t = 0.f;
#pragma unroll
            for (int j = 0; j < 4; ++j) t += (v[q][j][0]*v[q][j][0] + v[q][j][1]*v[q][j][1]) + (v[q][j][2]*v[q][j][2] + v[q][j][3]*v[q][j][3]);
            ss[q] = t; }
#pragma unroll
        for (int o = 1; o < 64; o <<= 1) {
#pragma unroll
            for (int q = 0; q < 4; ++q) ss[q] += __shfl_xor(ss[q], o); }
#pragma unroll
        for (int j = 0; j < 4; ++j) { const int c = j * 256 + lane * 4; const f32x4 g = *(const f32x4*)(P.g_norm + c);
#pragma unroll
            for (int q = 0; q < 4; ++q) { const float rq = rsqrtf(ss[q] * (1.f / DM) + EPS); const f32x4 y = v[q][j] * rq * g;
                __hip_atomic_store((unsigned long long*)((bf16_t*)(P.ws + WS_XN) + (size_t)(m0 + q) * DM + c), (unsigned long long)pk2(y[0], y[1]) | ((unsigned long long)pk2(y[2], y[3]) << 32), __ATOMIC_RELAXED, __HIP_MEMORY_SCOPE_AGENT); } }
    }
    if (SIGNAL) prep_signal(cnt, lane);
}
__device__ __forceinline__ void p0_prep(const Ptrs& P, LAS unsigned char* lds, int wave, int lane) {
    LAS float* scr = (LAS float*)(lds + wave * 16384);
    const int gw = blockIdx.x * NWAVES + wave, NGW = gridDim.x * NWAVES;
    constexpr int I_IN = (1024 / 64) * (INC / 32);
    for (int it = gw; it < I_IN; it += NGW) p0_transpose_item(P.w_in, 1024, INC, (bf16_t*)(P.ws + WS_WIN), scr, it, lane);
    if (gw == 0 && lane == 0) { float s1 = 0.f, s2 = 0.f; for (int i = 0; i < 32; ++i) { s1 += P.lq1[i] * P.lk1[i]; s2 += P.lq2[i] * P.lk2[i]; }
        *(float*)(P.ws + WS_MISC) = __expf(s1) - __expf(s2) + LAM_INIT; }
    prep_rows64<true>(P, (int)(blockIdx.x & 7u) * 5 * 2048 + (int)(blockIdx.x >> 3) * 64, wave, lane, (unsigned*)(P.ws + WS_CTL) + CW_PREP + (int)(blockIdx.x & 7u) * 5 * 64);
}
struct InProjOrder : pg8::StaticOrder {
    const Ptrs* P; unsigned* cnt; int wave, lane, xcd, slot; mutable int ready_gid; mutable unsigned* pend;
    __device__ __forceinline__ bool next(int i, pg8::Unit& u) const {
        if (pend) { prep_signal(pend, lane); pend = nullptr; }
        if (i <= 11 && i % 3 == slot % 3) { const int gid = xcd * 5 + i / 3 + 1; prep_rows64<false>(*P, gid * 2048 + slot * 64, wave, lane, nullptr); pend = cnt + gid * 64; }
        return pg8::StaticOrder::next(i, u);
    }
    __device__ __forceinline__ void a_ready(const pg8::Unit& u) const {
        const int gid = u.pm >> 3;
        if (gid != ready_gid) { while (__hip_atomic_load(cnt + gid * 64, __ATOMIC_RELAXED, __HIP_MEMORY_SCOPE_AGENT) < 256u) __builtin_amdgcn_s_sleep(4); ready_gid = gid; }
    }
};
__device__ __forceinline__ void wt_item(const Ptrs& P, LAS unsigned char* lds, int item, int wave, int lane) {
    constexpr int I_SQ = (1024 / 64) * (1024 / 32), I_PLE = (256 / 64) * (1024 / 32);
    LAS float* scr = (LAS float*)(lds + wave * 16384); int r = item * 8 + wave;
    if (r < I_SQ) { p0_transpose_item(P.w_out, 1024, 1024, (bf16_t*)(P.ws + WS_WOUT), scr, r, lane); return; } r -= I_SQ;
    if (r < I_SQ) { p0_transpose_item(P.w_pg, 1024, 1024, (bf16_t*)(P.ws + WS_WPG), scr, r, lane); return; } r -= I_SQ;
    if (r < I_PLE) p0_transpose_item(P.w_ple, 256, 1024, (bf16_t*)(P.ws + WS_WPLE), scr, r, lane);
}
__device__ __forceinline__ void pb_item(const Ptrs& P, int panel, int wave, int lane) {
    const int base = panel * 256;
    for (int r = wave; r < 64; r += 8) {
        f32x4 t[4];
#pragma unroll
        for (int k = 0; k < 4; ++k) t[k] = *(const f32x4*)(prow(P, base + r + 64 * k) + lane * 4);
#pragma unroll
        for (int k = 0; k < 4; ++k) { uint2 o; o.x = pk2(t[k][0], t[k][1]); o.y = pk2(t[k][2], t[k][3]); *(uint2*)((bf16_t*)(P.ws + WS_PB) + (size_t)(base + r + 64 * k) * PLE + lane * 4) = o; }
    }
}
struct Deq { unsigned* qctl; unsigned xcc; volatile LAS unsigned* misc;
    __device__ __forceinline__ void operator()() const { int item = -1, q = (int)misc[17];
        while (q < 8) { const unsigned x = (xcc + (unsigned)q) & 7u; const unsigned j = __hip_atomic_fetch_add(qctl + 64 * x, 1u, __ATOMIC_RELAXED, __HIP_MEMORY_SCOPE_AGENT); if (j < 402u) { item = (int)(x * 1024u + j); break; } ++q; }
        misc[16] = (unsigned)item; misc[17] = (unsigned)q; } };
namespace att {
typedef short bf16x8 __attribute__((ext_vector_type(8)));
typedef short s16x4 __attribute__((ext_vector_type(4)));
typedef float f32x16 __attribute__((ext_vector_type(16)));
typedef short v4i16_t __attribute__((ext_vector_type(4)));
constexpr int SLOT = 8192;
__device__ __forceinline__ int crow(int r, int hi) { return (r & 3) + 8 * (r >> 2) + 4 * hi; }
__device__ __forceinline__ int t5_bucket(int rel) { const int n = rel < 0 ? -rel : rel; int v = n; if (n >= 8) { v = 2 + (31 - __clz(n * n)); v = v > 15 ? 15 : v; } return (rel > 0 ? 16 : 0) + v; }
__device__ __forceinline__ s16x4 vtr(const LAS unsigned char* p) { return __builtin_bit_cast(s16x4, __builtin_amdgcn_ds_read_tr16_b64_v4i16((LAS v4i16_t*)p)); }
#define ATT_MFMA(a, b, c) __builtin_amdgcn_mfma_f32_32x32x16_bf16(a, b, c, 0, 0, 0)

#define SBAR() __builtin_amdgcn_sched_barrier(0)
#define PIN(x) asm volatile("" : "+v"(x))
#define WAIT_BAR(N) asm volatile("s_waitcnt vmcnt(" #N ") lgkmcnt(0)\n\ts_barrier" ::: "memory")
__device__ __forceinline__ void glds16(const void* g, unsigned lds_base) {
    asm volatile("s_mov_b32 m0, %1\n\ts_nop 0\n\tglobal_load_lds_dwordx4 %0, off" :: "v"(g), "s"(lds_base) : "memory", "m0"); }
constexpr int KSLOTS = 4, K2OFF = 0, V2OFF = KSLOTS * SLOT, DLT2_OFF = V2OFF + 4 * SLOT, WSF2_OFF = DLT2_OFF + 2048, STG2_OFF = WSF2_OFF + 2048;
static_assert(STG2_OFF + 8 * SLOT <= MISC_OFF, "attention LDS");
__device__ __forceinline__ void attn_unit(LAS unsigned char* lds, const Ptrs& P, const float lam, const int S, const size_t rowbase, const int h, const int qb, const Deq& nx) {
    int tid_ = threadIdx.x; asm volatile("" : "+v"(tid_));
    const int tid = tid_, lane = tid & 63, r32 = lane & 31, hi = lane >> 5; const int wid = __builtin_amdgcn_readfirstlane(tid >> 6);
    const int qw = qb * 256 + wid * 32;
    const bf16_t* Qg = (const bf16_t*)(P.ws + WS_Q) + (rowbase + qw) * 512 + h * 64;
    const bf16_t* Kg = (const bf16_t*)(P.ws + WS_K) + rowbase * 512 + h * 64;
    const bf16_t* Vg = (const bf16_t*)(P.ws + WS_V) + rowbase * 512 + h * 64;
    LAS float* dlt = (LAS float*)(lds + DLT2_OFF); LAS float* wsf = (LAS float*)(lds + WSF2_OFF) + wid * 64; LAS float* stg = (LAS float*)(lds + STG2_OFF) + wid * 2048;
    const unsigned lds0 = (unsigned)(uintptr_t)lds;
    const float c_lo = P.rel_bias[15 * NH + h] * LOG2E, c_hi = P.rel_bias[31 * NH + h] * LOG2E;
    const float hi_scale = exp2f(c_lo - c_hi);
    const int NT = S / 64;
    const bf16_t* ksrc = Kg + (size_t)lane * 512 + wid * 8;
    const bf16_t* vsrc = Vg + (size_t)(16 * (wid & 3) + (lane >> 2)) * 512 + (wid >> 2) * 32 + (lane & 3) * 8;
    const unsigned kdst = lds0 + K2OFF + wid * 1024, vdst = lds0 + V2OFF + wid * 1024;
#define DMA_K(t, slot) glds16(ksrc + (size_t)((t) < NT ? (t) : NT - 1) * 64 * 512, (unsigned)__builtin_amdgcn_readfirstlane(kdst + (slot)))
#define DMA_V(t, slot) glds16(vsrc + (size_t)((t) < NT ? (t) : NT - 1) * 64 * 512, (unsigned)__builtin_amdgcn_readfirstlane(vdst + (slot)))
    dlt[tid] = P.rel_bias[t5_bucket(tid - 256) * NH + h] * LOG2E - c_lo;
    DMA_K(0, 0); DMA_V(0, 0); DMA_K(1, SLOT); DMA_V(1, SLOT); DMA_K(2, 2 * SLOT); DMA_V(2, 2 * SLOT);
    bf16x8 qr[4];
#pragma unroll
    for (int d0 = 0; d0 < 4; ++d0) qr[d0] = *(const bf16x8*)(Qg + (size_t)r32 * 512 + d0 * 16 + hi * 8);
    f32x16 o00, o01, o10, o11, X0, X1, Y0, Y1;
#pragma unroll
    for (int r = 0; r < 16; ++r) { o00[r] = 0.f; o01[r] = 0.f; o10[r] = 0.f; o11[r] = 0.f; Y0[r] = 0.f; Y1[r] = 0.f; }
    float l0 = 0.f, l0b = 0.f, l1 = 0.f, l1b = 0.f; bool in_hi = false;
    s16x4 vlo[8], vhi[8]; u32x4 pw0, pw1, pw2, pw3; bf16x8 kfa[4], kfb[4];
#pragma unroll
    for (int i = 0; i < 8; ++i) { vlo[i] = (s16x4){0, 0, 0, 0}; vhi[i] = (s16x4){0, 0, 0, 0}; }
    unsigned ones2 = 0x3f803f80u; asm volatile("" : "+s"(ones2));
    f32x16 zero16;
#pragma unroll
    for (int r = 0; r < 16; ++r) zero16[r] = 0.f;
    const LAS unsigned char* kp0 = lds + K2OFF + hi * 1024 + r32 * 16;
    const LAS unsigned char* vp0 = lds + V2OFF + ((lane >> 4) & 1) * 32 + (lane & 3) * 8 + (4 * hi + ((lane & 15) >> 2)) * 64;
    __builtin_amdgcn_s_waitcnt(0x0F70);
    WAIT_BAR(1);
#pragma unroll
    for (int i = 0; i < 4; ++i) kfa[i] = *(const LAS bf16x8*)(kp0 + (i >> 1) * 2048 + (i & 1) * 512);
#define KLD(kf, base, c, i) kf[i] = *(const LAS bf16x8*)((base) + (2 * (c) + ((i) >> 1)) * 2048 + ((i) & 1) * 512)
#define VRD(i, vb) do { vlo[i] = vtr((vb) + (((i) >> 2) * 4096 + ((i) & 3) * 1024)); vhi[i] = vtr((vb) + (((i) >> 2) * 4096 + ((i) & 3) * 1024 + 512)); } while (0)
#define VFR(i) (bf16x8){vlo[i][0], vlo[i][1], vlo[i][2], vlo[i][3], vhi[i][0], vhi[i][1], vhi[i][2], vhi[i][3]}
#define PAF(k) __builtin_bit_cast(bf16x8, pw##k)
#define DOT1(acc, w) acc = __builtin_amdgcn_fdot2_f32_bf16(__builtin_bit_cast(bf16x2_t, (w)), __builtin_bit_cast(bf16x2_t, ones2), acc, false)
#define GAPA(MF, Pv, B, PW, sacc, saccb) do { MF; unsigned w0_ = pk2(Pv[B], Pv[B + 1]), w1_ = pk2(Pv[B + 2], Pv[B + 3]), w2_ = pk2(Pv[B + 4], Pv[B + 5]), w3_ = pk2(Pv[B + 6], Pv[B + 7]); \
        PIN(w0_); PIN(w1_); PIN(w2_); PIN(w3_); DOT1(sacc, w0_); DOT1(saccb, w1_); DOT1(sacc, w2_); DOT1(saccb, w3_); PW = (u32x4){w0_, w1_, w2_, w3_}; PIN(sacc); PIN(saccb); SBAR(); } while (0)
#define EX(v) __builtin_amdgcn_exp2f(v)
#define GAPB(MF, Xv, B) do { MF; Xv[B] = EX(Xv[B]); Xv[B + 1] = EX(Xv[B + 1]); Xv[B + 2] = EX(Xv[B + 2]); Xv[B + 3] = EX(Xv[B + 3]); PIN(Xv); SBAR(); } while (0)
#define NEARADD(A0, A1) do { if (near) { const int ib = k0 - (qw + r32) + 256 + 4 * hi; \
        _Pragma("unroll") for (int r = 0; r < 16; ++r) { const int ix = ib + (r & 3) + 8 * (r >> 2); A0[r] += dlt[ix]; A1[r] += dlt[ix + 32]; } } } while (0)
    for (int t = 0; t < NT; ++t) {
        const int k0 = t * 64;
        const LAS unsigned char* kpc = kp0 + (t & 3) * SLOT; const LAS unsigned char* kpn = kp0 + ((t + 1) & 3) * SLOT;
        const LAS unsigned char* vpc = vp0 + (t & 3) * SLOT;
        DMA_K(t + 3, ((t + 3) & 3) * SLOT); DMA_V(t + 3, ((t + 3) & 3) * SLOT);
        const bool near = (k0 > qw - 154) && (k0 < qw + 122);
        if (k0 >= qw + 122 && !in_hi) { in_hi = true; l0 *= hi_scale; l1 *= hi_scale; l0b *= hi_scale; l1b *= hi_scale;
            o00 = o00 * hi_scale; o01 = o01 * hi_scale; o10 = o10 * hi_scale; o11 = o11 * hi_scale; Y0 = Y0 * hi_scale; Y1 = Y1 * hi_scale; }
        SBAR();
        GAPA(X0 = ATT_MFMA(kfa[0], qr[0], zero16), Y0, 0, pw0, l1, l1b);
        GAPA(X1 = ATT_MFMA(kfa[1], qr[0], zero16), Y0, 8, pw1, l1, l1b);
        GAPA(X0 = ATT_MFMA(kfa[2], qr[1], X0), Y1, 0, pw2, l1, l1b);
        GAPA(X1 = ATT_MFMA(kfa[3], qr[1], X1), Y1, 8, pw3, l1, l1b);
        NEARADD(X0, X1); SBAR();
        GAPB(o10 = ATT_MFMA(PAF(0), VFR(0), o10), X0, 0);
        GAPB(o11 = ATT_MFMA(PAF(0), VFR(4), o11), X0, 4);
        KLD(kfb, kpc, 1, 0); SBAR(); GAPB(o10 = ATT_MFMA(PAF(1), VFR(1), o10), X0, 8);
        KLD(kfb, kpc, 1, 1); SBAR(); GAPB(o11 = ATT_MFMA(PAF(1), VFR(5), o11), X0, 12);
        KLD(kfb, kpc, 1, 2); SBAR(); GAPB(o10 = ATT_MFMA(PAF(2), VFR(2), o10), X1, 0);
        KLD(kfb, kpc, 1, 3); SBAR(); GAPB(o11 = ATT_MFMA(PAF(2), VFR(6), o11), X1, 4);
        GAPB(o10 = ATT_MFMA(PAF(3), VFR(3), o10), X1, 8);
        GAPB(o11 = ATT_MFMA(PAF(3), VFR(7), o11), X1, 12);
        VRD(0, vpc); VRD(4, vpc); SBAR(); GAPA(Y0 = ATT_MFMA(kfb[0], qr[2], zero16), X0, 0, pw0, l0, l0b);
        VRD(1, vpc); VRD(5, vpc); SBAR(); GAPA(Y1 = ATT_MFMA(kfb[1], qr[2], zero16), X0, 8, pw1, l0, l0b);
        VRD(2, vpc); VRD(6, vpc); SBAR(); GAPA(Y0 = ATT_MFMA(kfb[2], qr[3], Y0), X1, 0, pw2, l0, l0b);
        VRD(3, vpc); VRD(7, vpc); SBAR(); GAPA(Y1 = ATT_MFMA(kfb[3], qr[3], Y1), X1, 8, pw3, l0, l0b);
        NEARADD(Y0, Y1); SBAR();
        GAPB(o00 = ATT_MFMA(PAF(0), VFR(0), o00), Y0, 0);
        GAPB(o01 = ATT_MFMA(PAF(0), VFR(4), o01), Y0, 4);
        KLD(kfa, kpn, 0, 0); SBAR(); GAPB(o00 = ATT_MFMA(PAF(1), VFR(1), o00), Y0, 8);
        KLD(kfa, kpn, 0, 1); SBAR(); GAPB(o01 = ATT_MFMA(PAF(1), VFR(5), o01), Y0, 12);
        KLD(kfa, kpn, 0, 2); SBAR(); GAPB(o00 = ATT_MFMA(PAF(2), VFR(2), o00), Y1, 0);
        KLD(kfa, kpn, 0, 3); SBAR(); GAPB(o01 = ATT_MFMA(PAF(2), VFR(6), o01), Y1, 4);
        GAPB(o00 = ATT_MFMA(PAF(3), VFR(3), o00), Y1, 8);
        GAPB(o01 = ATT_MFMA(PAF(3), VFR(7), o01), Y1, 12);
        __builtin_amdgcn_s_waitcnt(0x0073); asm volatile("s_barrier" ::: "memory");
    }
    if (tid == 0) nx();
    u32x4 gav[4];
    { const size_t grow = rowbase + qw + (lane >> 1); const bf16_t* ga = (const bf16_t*)(P.ws + WS_GA) + grow * 512 + h * 64 + (lane & 1) * 32;
#pragma unroll
      for (int j = 0; j < 4; ++j) gav[j] = *(const u32x4*)(ga + 8 * j); }
    { float sacc = l1, saccb = l1b;
#define DRAINW(PW, Pv, B) do { unsigned w0_ = pk2(Pv[B], Pv[B + 1]), w1_ = pk2(Pv[B + 2], Pv[B + 3]), w2_ = pk2(Pv[B + 4], Pv[B + 5]), w3_ = pk2(Pv[B + 6], Pv[B + 7]); \
        PIN(w0_); PIN(w1_); PIN(w2_); PIN(w3_); DOT1(sacc, w0_); DOT1(saccb, w1_); DOT1(sacc, w2_); DOT1(saccb, w3_); PW = (u32x4){w0_, w1_, w2_, w3_}; } while (0)
      DRAINW(pw0, Y0, 0); DRAINW(pw1, Y0, 8); DRAINW(pw2, Y1, 0); DRAINW(pw3, Y1, 8);
      l1 = sacc + saccb; l0 += l0b;
      o10 = ATT_MFMA(PAF(0), VFR(0), o10); o11 = ATT_MFMA(PAF(0), VFR(4), o11); o10 = ATT_MFMA(PAF(1), VFR(1), o10); o11 = ATT_MFMA(PAF(1), VFR(5), o11);
      o10 = ATT_MFMA(PAF(2), VFR(2), o10); o11 = ATT_MFMA(PAF(2), VFR(6), o11); o10 = ATT_MFMA(PAF(3), VFR(3), o10); o11 = ATT_MFMA(PAF(3), VFR(7), o11); }
    { auto r0 = __builtin_amdgcn_permlane32_swap(__float_as_uint(l0), __float_as_uint(l0), false, false); l0 = __uint_as_float(r0[0]) + __uint_as_float(r0[1]);
      auto r1 = __builtin_amdgcn_permlane32_swap(__float_as_uint(l1), __float_as_uint(l1), false, false); l1 = __uint_as_float(r1[0]) + __uint_as_float(r1[1]); }
    if (hi == 0) { wsf[r32] = 1.f / l0; wsf[32 + r32] = lam / l1; }
    asm volatile("s_waitcnt lgkmcnt(0)" ::: "memory");
#pragma unroll
    for (int r = 0; r < 16; ++r) { const int q = crow(r, hi); const float a0 = wsf[q], a1 = wsf[32 + q];
        stg[q * 64 + r32] = o00[r] * a0 - o10[r] * a1; stg[q * 64 + 32 + r32] = o01[r] * a0 - o11[r] * a1; }
    asm volatile("s_waitcnt lgkmcnt(0)" ::: "memory");
    { const int row = lane >> 1, hf = lane & 1; const LAS float* sr = stg + row * 64 + hf * 32; f32x4 v[8]; float ss = 0.f;
#pragma unroll
      for (int j = 0; j < 8; ++j) { v[j] = *(const LAS f32x4*)(sr + 4 * j); ss += (v[j][0]*v[j][0] + v[j][1]*v[j][1]) + (v[j][2]*v[j][2] + v[j][3]*v[j][3]); }
      ss += __shfl_xor(ss, 1);
      const float rs = rsqrtf(ss * (1.f / 64.f) + EPS) * (1.f - LAM_INIT);
      const size_t grow = rowbase + qw + row;
      bf16_t* mix = (bf16_t*)(P.ws + WS_MIX) + grow * DM + h * 64 + hf * 32;
      const float* sn = P.sub_norm + hf * 32;
#pragma unroll
      for (int j = 0; j < 4; ++j) { const u32x4 g = gav[j]; const f32x4 n0 = *(const f32x4*)(sn + 8 * j), n1 = *(const f32x4*)(sn + 8 * j + 4); const f32x4 a = v[2*j] * rs * n0, b = v[2*j+1] * rs * n1;
          u32x4 w; w.x = pk2(a[0] * bf2f(g.x & 0xffff), a[1] * bf2f(g.x >> 16)); w.y = pk2(a[2] * bf2f(g.y & 0xffff), a[3] * bf2f(g.y >> 16));
          w.z = pk2(b[0] * bf2f(g.z & 0xffff), b[1] * bf2f(g.z >> 16)); w.w = pk2(b[2] * bf2f(g.w & 0xffff), b[3] * bf2f(g.w >> 16));
          *(u32x4*)(mix + 8 * j) = w; }
    }
    WAIT_BAR(0);
#undef DMA_K
#undef DMA_V
}
}


namespace lru {
typedef short bf16x8 __attribute__((ext_vector_type(8)));
typedef float f32x16 __attribute__((ext_vector_type(16)));
constexpr int T = 64, YBS = 72;
constexpr int XS_OFF = 0, YB_OFF = 8704, HT_OFF = YB_OFF + 9216, AG_OFF = HT_OFF + 16384, DIR_BYTES = AG_OFF + 1024;
static_assert(2 * DIR_BYTES <= 131072, "LRU LDS");
template <int DIR> __device__ __forceinline__ void scan_pre(const float (&a)[16], const float (&b)[16], int hi, float (&Pin)[4], float (&Cin)[4], float& Ah, float& Hh) {
    float Ag[4], Hg[4], pA[4], pH[4];
#pragma unroll
    for (int g = 0; g < 4; ++g) { float A = 1.f, H = 0.f;
#pragma unroll
        for (int qq = 0; qq < 4; ++qq) { const int r = 4 * g + (DIR ? 3 - qq : qq); H = a[r] * H + b[r]; A *= a[r]; }
        Ag[g] = A; Hg[g] = H; pA[g] = __shfl_xor(A, 32); pH[g] = __shfl_xor(H, 32); }
    float Pc = 1.f, Cc = 0.f;
    const bool own_first = DIR ? (hi == 1) : (hi == 0);
#pragma unroll
    for (int s = 0; s < 4; ++s) { const int g = DIR ? 3 - s : s;
        const float A1 = own_first ? Ag[g] : pA[g], H1 = own_first ? Hg[g] : pH[g], A2 = own_first ? pA[g] : Ag[g], H2 = own_first ? pH[g] : Hg[g];
        const float C1 = A1 * Cc + H1, P1 = Pc * A1;
        Pin[g] = own_first ? Pc : P1; Cin[g] = own_first ? Cc : C1;
        Cc = A2 * C1 + H2; Pc = P1 * A2; }
    Ah = Pc; Hh = Cc;
}
template <int DIR> __device__ __forceinline__ void scan_post(const float (&a)[16], const float (&b)[16], const float (&Pin)[4], const float (&Cin)[4], float cin, float (&h)[16]) {
#pragma unroll
    for (int g = 0; g < 4; ++g) { float C = Pin[g] * cin + Cin[g];
#pragma unroll
        for (int qq = 0; qq < 4; ++qq) { const int r = 4 * g + (DIR ? 3 - qq : qq); C = a[r] * C + b[r]; h[r] = C; } }
}
__device__ __forceinline__ void lru_unit(LAS unsigned char* lds0, const Ptrs& P, const int sq, const int n, const Deq& nx) {
    int tid_ = threadIdx.x; asm volatile("" : "+v"(tid_));
    const int tid = tid_, lane = tid & 63, r32 = lane & 31, hi = lane >> 5; const int wid = __builtin_amdgcn_readfirstlane(tid >> 6);
    const int dir = wid >> 2, w4 = wid & 3, tid4 = tid & 255, tb = w4 & 1, cbk = w4 >> 1;
    const int S = sq < BP ? SP : SS; const size_t rowbase = sq < BP ? (size_t)sq * SP : (size_t)MP + (size_t)(sq - BP) * SS;
    LAS unsigned char* lds = lds0 + dir * DIR_BYTES;
    LAS bf16_t* xs = (LAS bf16_t*)(lds + XS_OFF); LAS bf16_t* yb = (LAS bf16_t*)(lds + YB_OFF); LAS float* ht = (LAS float*)(lds + HT_OFF); LAS float* agg = (LAS float*)(lds + AG_OFF);
    const int ch = cbk * 32 + r32, gch = n * 64 + ch;
    const bf16_t* XRb = (const bf16_t*)(P.ws + WS_XR) + rowbase * 512 + n * 64;
    const bf16_t* GLb = (const bf16_t*)(P.ws + WS_GL) + rowbase * 512 + n * 64;
    float* HSmine = (float*)(P.ws + (dir ? WS_HSB : WS_HSF)) + rowbase * 512 + n * 64; const float* HSoth = (const float*)(P.ws + (dir ? WS_HSF : WS_HSB)) + rowbase * 512 + n * 64;
    bf16_t* MIXb = (bf16_t*)(P.ws + WS_MIX) + rowbase * DM + 512 + n * 64;
    const float cw0 = P.conv_w[gch], cw1 = P.conv_w[512 + gch], cw2 = P.conv_w[1024 + gch], cw3 = P.conv_w[1536 + gch], cb = P.conv_b[gch];
    const float* Wa = P.w_a + (size_t)(dir * 8 + n) * 4096; const float* Wx = P.w_x + (size_t)(dir * 8 + n) * 4096;
    bf16x8 wfa[4], wfx[4];
#pragma unroll
    for (int ks = 0; ks < 4; ++ks)
#pragma unroll
        for (int j = 0; j < 8; ++j) { wfa[ks][j] = (short)f2bf(-LOG2E * Wa[(16 * ks + 8 * hi + j) * 64 + ch]); wfx[ks][j] = (short)f2bf(-LOG2E * Wx[(16 * ks + 8 * hi + j) * 64 + ch]); }
    const float ba = -LOG2E * P.b_a[dir * 512 + gch], bx = -LOG2E * P.b_x[dir * 512 + gch];
    f32x16 biasA, biasX;
#pragma unroll
    for (int r = 0; r < 16; ++r) { biasA[r] = ba; biasX[r] = bx; }
    const float lmb = P.lam[dir * 512 + gch];
    const float c8 = -8.f * LOG2E * (lmb > 15.f ? __expf(-lmb) : log1pf(__expf(-lmb)));
    const int NC = S / T;
    auto xload = [&](int c, u32x4& p0, u32x4& p1, u32x4& p2) {
        const int t0 = c * T; const u32x4 z = {0u, 0u, 0u, 0u};
        { const int r = tid4 >> 3, pc = tid4 & 7; const int t = t0 - 2 + r; p0 = (t >= 0 && t < S) ? *(const u32x4*)(XRb + (size_t)t * 512 + pc * 8) : z; }
        { const int r = 32 + (tid4 >> 3), pc = tid4 & 7; const int t = t0 - 2 + r; p1 = (t >= 0 && t < S) ? *(const u32x4*)(XRb + (size_t)t * 512 + pc * 8) : z; }
        { const int r = 64 + (tid4 >> 3), pc = tid4 & 7; const int t = t0 - 2 + r; p2 = (tid4 < 24 && t >= 0 && t < S) ? *(const u32x4*)(XRb + (size_t)t * 512 + pc * 8) : z; }
    };
    u32x4 xp0, xp1, xp2; xload(dir ? NC - 1 : 0, xp0, xp1, xp2);
    float car = 0.f;
    const bool first = dir ? (tb == 1) : (tb == 0);
    __syncthreads();
    for (int i = 0; i < NC; ++i) {
        const int c = dir ? NC - 1 - i : i, t0 = c * T; const bool comb = i >= NC / 2;
        if (i == NC - 1 && tid == 0) nx();
        { const int r = tid4 >> 3, pc = tid4 & 7; *(LAS u32x4*)(xs + r * 64 + pc * 8) = xp0; *(LAS u32x4*)(xs + (32 + r) * 64 + pc * 8) = xp1; if (tid4 < 24) *(LAS u32x4*)(xs + (64 + r) * 64 + pc * 8) = xp2; }
        asm volatile("s_waitcnt vmcnt(0)" ::: "memory");
        __syncthreads();
        if (i + 1 < NC) xload(dir ? NC - 2 - i : i + 1, xp0, xp1, xp2);
        f32x4 oth[4]; uint2 glv[4];
#pragma unroll
        for (int k = 0; k < 4; ++k) { const int idx = tid4 + 256 * k, row = idx >> 4, c4 = idx & 15; const size_t off = (size_t)(t0 + row) * 512 + c4 * 4;
            if (comb) { oth[k] = *(const f32x4*)(HSoth + off); glv[k] = *(const uint2*)(GLb + off); } else { oth[k] = (f32x4){0.f, 0.f, 0.f, 0.f}; glv[k] = make_uint2(0u, 0u); } }
        float y[16];
#pragma unroll
        for (int g = 0; g < 4; ++g) { const int base = 32 * tb + 8 * g + 4 * hi; float xv[7];
#pragma unroll
            for (int j = 0; j < 7; ++j) xv[j] = bf2f(xs[(base + j) * 64 + ch]);
#pragma unroll
            for (int q = 0; q < 4; ++q) { const float yy = cb + cw0 * xv[q] + cw1 * xv[q + 1] + cw2 * xv[q + 2] + cw3 * xv[q + 3]; y[4 * g + q] = yy; yb[(base + q) * YBS + ch] = (bf16_t)(pk2(yy, 0.f) & 0xffffu); } }
        __syncthreads();
        f32x16 acca, accx;
#pragma unroll
        for (int ks = 0; ks < 4; ++ks) { const bf16x8 af = *(const LAS bf16x8*)(yb + (tb * 32 + r32) * YBS + 16 * ks + 8 * hi);
            acca = __builtin_amdgcn_mfma_f32_32x32x16_bf16(af, wfa[ks], ks == 0 ? biasA : acca, 0, 0, 0); accx = __builtin_amdgcn_mfma_f32_32x32x16_bf16(af, wfx[ks], ks == 0 ? biasX : accx, 0, 0, 0); }
        float a[16], b[16];
#pragma unroll
        for (int r = 0; r < 16; ++r) { const float rg = __builtin_amdgcn_rcpf(1.f + __builtin_amdgcn_exp2f(acca[r])), ig = __builtin_amdgcn_rcpf(1.f + __builtin_amdgcn_exp2f(accx[r]));
            const float av = __builtin_amdgcn_exp2f(c8 * rg); a[r] = av; b[r] = __builtin_amdgcn_sqrtf(fmaxf(1.f - av * av, 0.f)) * ig * y[r]; }
        float Pin[4] = {1.f, 1.f, 1.f, 1.f}, Cin[4] = {0.f, 0.f, 0.f, 0.f}, Ah, Hh;
        if (dir == 0) scan_pre<0>(a, b, hi, Pin, Cin, Ah, Hh); else scan_pre<1>(a, b, hi, Pin, Cin, Ah, Hh);
        if (hi == 0) { agg[(tb * 64 + ch) * 2] = Ah; agg[(tb * 64 + ch) * 2 + 1] = Hh; }
        __syncthreads();
        const float Ao = agg[((tb ^ 1) * 64 + ch) * 2], Ho = agg[((tb ^ 1) * 64 + ch) * 2 + 1];
        const float cin = first ? car : Ao * car + Ho;
        car = first ? Ao * (Ah * car + Hh) + Ho : Ah * cin + Hh;
        float h[16];
        if (dir == 0) scan_post<0>(a, b, Pin, Cin, cin, h); else scan_post<1>(a, b, Pin, Cin, cin, h);
#pragma unroll
        for (int r = 0; r < 16; ++r) ht[(32 * tb + ((r & 3) + 8 * (r >> 2) + 4 * hi)) * 64 + ch] = h[r];
        __syncthreads();
#pragma unroll
        for (int k = 0; k < 4; ++k) { const int idx = tid4 + 256 * k, row = idx >> 4, c4 = idx & 15; const size_t off = (size_t)(t0 + row) * 512 + c4 * 4;
            const f32x4 h4 = *(const LAS f32x4*)(ht + row * 64 + c4 * 4);
            if (!comb) *(f32x4*)(HSmine + off) = h4;
            else { const f32x4 sm = h4 + oth[k]; uint2 o; o.x = pk2(sm[0] * bf2f(glv[k].x & 0xffff), sm[1] * bf2f(glv[k].x >> 16)); o.y = pk2(sm[2] * bf2f(glv[k].y & 0xffff), sm[3] * bf2f(glv[k].y >> 16));
                   *(uint2*)(MIXb + (size_t)(t0 + row) * DM + c4 * 4) = o; } }
    }
}
}

typedef __attribute__((address_space(1))) unsigned gu32;
#define XB_TMO      128
#define XB_XCNT(j)  (256  + 64 * (j))
#define XB_XSUB(j)  (1280 + 64 * (j))
#define XB_XGEN(j)  (2304 + 64 * (j))
#define XB_TOP      3328
#define XB_TOPGEN   3392
#define XCD_BAR_WORDS 3456
#define XB_SPIN_CAP (1u << 18)

__device__ __forceinline__ unsigned xb_ld(unsigned* p)              { return __hip_atomic_load(p, __ATOMIC_RELAXED, __HIP_MEMORY_SCOPE_AGENT); }
__device__ __forceinline__ unsigned xb_add(unsigned* p, unsigned v) { return __hip_atomic_fetch_add(p, v, __ATOMIC_RELAXED, __HIP_MEMORY_SCOPE_AGENT); }
__device__ __forceinline__ unsigned xb_xcc_id() { return (unsigned)__builtin_amdgcn_s_getreg((3 << 11) | 20) & 0xFu; }
#define XB_SPIN(cond, bar) do { unsigned _sp = 0; while (cond) { __builtin_amdgcn_s_sleep(1); \
    if ((++_sp & 255u) == 0u) { if (xb_ld(&(bar)[XB_TMO])) break; if (_sp > XB_SPIN_CAP) { atomicAdd(&(bar)[XB_TMO], 1u); break; } } } } while (0)

struct XcdBarrier {
    unsigned* bar; unsigned x;
    volatile LAS unsigned* st;
};

__device__ __forceinline__ XcdBarrier xcd_barrier_post(unsigned* bar, volatile LAS unsigned* st) {
    XcdBarrier b; b.bar = bar; b.x = xb_xcc_id(); b.st = st;
    if (threadIdx.x == 0) (void)xb_add(&bar[XB_XCNT(b.x)], 1u);
    return b;
}
__device__ __forceinline__ void xcd_barrier_complete(unsigned* bar, unsigned x, unsigned& nloc, unsigned& nx) {
    const unsigned G = gridDim.x * gridDim.y * gridDim.z;
    unsigned sum, cnt, mine, sp = 0u;
    for (;;) {
        sum = 0u; cnt = 0u; mine = 0u;
#pragma unroll
        for (unsigned j = 0; j < 16; ++j) { const unsigned c = xb_ld(&bar[XB_XCNT(j)]); sum += c; cnt += (c > 0u) ? 1u : 0u; mine = (j == x) ? c : mine; }
        if (sum == G) break;
        __builtin_amdgcn_s_sleep(1);
        if ((++sp & 255u) == 0u) { if (xb_ld(&bar[XB_TMO])) break; if (sp > XB_SPIN_CAP) { atomicAdd(&bar[XB_TMO], 1u); break; } }
    }
    nloc = mine > 0u ? mine : 1u; nx = cnt > 0u ? cnt : 1u;
}

__device__ __forceinline__ void xcd_barrier(const XcdBarrier& b) {
    asm volatile("s_waitcnt vmcnt(0)" ::: "memory");
    __syncthreads();
    if (threadIdx.x == 0) {
        unsigned* bar = b.bar;
        __builtin_amdgcn_s_waitcnt(0);
        unsigned nloc = b.st[0], nx = b.st[1];
        if (nloc == 0u) { xcd_barrier_complete(bar, b.x, nloc, nx); b.st[0] = nloc; b.st[1] = nx; }
        const unsigned old = xb_add(&bar[XB_XSUB(b.x)], 1u);
        const unsigned gen = old / nloc;
        if (old + 1u == (gen + 1u) * nloc) {
            __builtin_amdgcn_fence(__ATOMIC_RELEASE, "agent");
            asm volatile("s_waitcnt vmcnt(0)" ::: "memory");
            const unsigned og = xb_add(&bar[XB_TOP], 1u);
            const unsigned tg = og / nx;
            if (og + 1u == (tg + 1u) * nx) xb_add(&bar[XB_TOPGEN], 1u);
            else XB_SPIN(xb_ld(&bar[XB_TOPGEN]) == tg, bar);
            __builtin_amdgcn_fence(__ATOMIC_ACQUIRE, "agent");
            xb_add(&bar[XB_XGEN(b.x)], 1u);
            asm volatile("s_waitcnt vmcnt(0)" ::: "memory");
        } else {
            XB_SPIN(xb_ld(&bar[XB_XGEN(b.x)]) == gen, bar);
            __builtin_amdgcn_fence(__ATOMIC_ACQUIRE, "agent");
            asm volatile("s_waitcnt vmcnt(0)" ::: "memory");
        }
    }
    __syncthreads();
}

struct Args { Ptrs P; int ph_lo, ph_hi; };
__global__ void __launch_bounds__(NTHREADS, 2) mk_fwd(Args a) {
    extern __shared__ __attribute__((aligned(16))) unsigned char lds_raw[];
    LAS unsigned char* lds = (LAS unsigned char*)lds_raw;
    const Ptrs& P = a.P; unsigned char* ws = P.ws;
    const int tid = threadIdx.x, lane = tid & 63, wave = __builtin_amdgcn_readfirstlane(tid >> 6);
    const int lo = a.ph_lo, hi = a.ph_hi;
#define IN(k) (lo <= (k) && (k) < hi)
#define BOTH(k) (IN(k) && IN((k) + 1))
    volatile LAS unsigned* MISC = (volatile LAS unsigned*)(lds + MISC_OFF);
    if (tid < 64) MISC[tid] = 0u;
    __syncthreads();
    XcdBarrier bar; bar.bar = (unsigned*)(ws + WS_CTL) + CW_BAR; bar.x = 0; bar.st = nullptr;
    if (hi - lo > 1) bar = xcd_barrier_post((unsigned*)(ws + WS_CTL) + CW_BAR, MISC + 8);
#define GRID_BAR() xcd_barrier(bar)
    if (IN(0)) { p0_prep(P, lds, wave, lane); if (BOTH(0)) GRID_BAR(); }
    if (IN(1)) { pg8::Gemm g{(const bf16_t*)(ws + WS_XN), (const bf16_t*)(ws + WS_WIN), MT, INC, 1024}; InProjOrder S; S.init(MT, INC, gridDim.x, blockIdx.x);
        S.P = &P; S.cnt = (unsigned*)(ws + WS_CTL) + CW_PREP; S.wave = wave; S.lane = lane; S.xcd = (int)(blockIdx.x & 7u); S.slot = (int)(blockIdx.x >> 3); S.ready_gid = -1; S.pend = nullptr;
        EpiIn E{ws, P.q_norm, P.k_norm}; pg8::gemm_phase<EpiIn, InProjOrder, true, true>(lds, g, S, E); if (BOTH(1)) GRID_BAR(); }
    if (IN(2)) {
        const float lam = *(const float*)(ws + WS_MISC);
        const Deq nx{(unsigned*)(ws + WS_CTL) + CW_QUEUE, xb_xcc_id() & 7u, MISC};
        if (tid == 0) { MISC[17] = 0u; nx(); }
        __syncthreads();
        for (;;) {
            const int item = (int)MISC[16];
            if (item < 0) break;
            const int x = item >> 10, j = item & 1023;
            if (j >= 384) { wt_item(P, lds, x * 18 + (j - 384), wave, lane); if (tid == 0) nx(); }
            else if (j >= 344) { pb_item(P, x * 40 + (j - 344), wave, lane); if (tid == 0) nx(); }
            else if (j < 24) { const int sq = j < 16 ? x * 2 + (j >> 3) : 16 + x, nb = j < 16 ? (j & 7) : j - 16; lru::lru_unit(lds, P, sq, nb, nx); }
            else { const bool pr = j < 280; const int j2 = pr ? j - 24 : j - 280; const int bh = pr ? x * 16 + (j2 >> 4) : x * 8 + (j2 >> 3);
                   att::attn_unit(lds, P, lam, pr ? SP : SS, pr ? (size_t)(bh >> 3) * SP : (size_t)MP + (size_t)(bh >> 3) * SS, bh & 7, pr ? (j2 & 15) : (j2 & 7), nx); }
            __syncthreads();
        }
        if (BOTH(2)) GRID_BAR(); }
    if (IN(3)) {
        pg8::Gemm g{(const bf16_t*)(ws + WS_PB), (const bf16_t*)(ws + WS_WPLE), MT, DM, 256}; pg8::StaticOrder S; S.init(MT, DM, gridDim.x, blockIdx.x);
        EpiStore E{(bf16_t*)(ws + WS_PW)}; pg8::gemm_phase<EpiStore, pg8::StaticOrder, true, true>(lds, g, S, E); }
    if (IN(4)) {
        pg8::Gemm g{(const bf16_t*)(ws + WS_MIX), (const bf16_t*)(ws + WS_WOUT), MT, DM, 1024}; pg8::StaticOrder S; S.init(MT, DM, gridDim.x, blockIdx.x);
        EpiOut E{P.xp, P.xs, P.out, (bf16_t*)(ws + WS_HB)}; pg8::gemm_phase<EpiOut, pg8::StaticOrder, true, true>(lds, g, S, E);
        if (BOTH(4)) GRID_BAR(); }
    if (IN(5)) {
        pg8::Gemm g{(const bf16_t*)(ws + WS_HB), (const bf16_t*)(ws + WS_WPG), MT, DM, 1024}; pg8::StaticOrder S; S.init(MT, DM, gridDim.x, blockIdx.x);
        EpiGateFinal E{(const bf16_t*)(ws + WS_PW), (const bf16_t*)(ws + WS_HB), P.out, P.g_ple, (float*)(ws + WS_HSF), (unsigned*)(ws + WS_CTL) + CW_PANEL}; pg8::gemm_phase<EpiGateFinal, pg8::StaticOrder, true, true>(lds, g, S, E); }
#undef IN
#undef BOTH
#undef GRID_BAR
}
extern "C" void kernel_launch(void* const* d_in, const int* in_sizes, int n_in, void* d_out, int out_size, void* d_ws, size_t ws_size, hipStream_t stream) {
    static int grid = 0;
    if (grid == 0) {
        if (n_in != 25 || out_size != MT * DM || ws_size < WS_END) { fprintf(stderr, "kernel_launch: unexpected shapes n_in %d out %d ws %zu\n", n_in, out_size, ws_size); grid = -1; return; }
        int dev = 0, cus = 0;
        if (hipGetDevice(&dev) != hipSuccess || hipDeviceGetAttribute(&cus, hipDeviceAttributeMultiprocessorCount, dev) != hipSuccess) { grid = -1; return; }
        if (hipFuncSetAttribute((const void*)mk_fwd, hipFuncAttributeMaxDynamicSharedMemorySize, LDS_BYTES) != hipSuccess) { fprintf(stderr, "kernel_launch: hipFuncSetAttribute failed\n"); grid = -1; return; }
        if (cus != 256) { fprintf(stderr, "kernel_launch: the row-group ownership of the prep assumes 256 CUs, found %d\n", cus); grid = -1; return; }
        grid = cus;
    }
    if (grid < 0) return;
    Args a{};
    const float** f = (const float**)&a.P;
    for (int i = 0; i < 25; ++i) f[i] = (const float*)d_in[i];
    a.P.out = (float*)d_out; a.P.ws = (unsigned char*)d_ws;
    hipMemsetAsync((char*)d_ws + WS_CTL, 0, CTL_ZERO_BYTES, stream);
    auto run = [&](int lo, int hi) { a.ph_lo = lo; a.ph_hi = hi; hipLaunchKernelGGL(mk_fwd, dim3(grid), dim3(NTHREADS), LDS_BYTES, stream, a); };
    run(0, 6);
}
```

```cpp
#include <hip/hip_runtime.h>
#include <cstdint>
#include <cstdio>
namespace pg8 {
#define PG8_LAS __attribute__((address_space(3)))
typedef unsigned short bf16_t;
typedef short bf16x8 __attribute__((ext_vector_type(8)));
typedef float f32x4 __attribute__((ext_vector_type(4)));
typedef unsigned u32x4 __attribute__((ext_vector_type(4)));
constexpr int BM = 256, BK = 64, HALF = 128, HTB = HALF * BK * 2  , STAGE_BYTES = 8 * HTB, NXCD = 8, WGM = 8;

__host__ __device__ __forceinline__ int lds_byte(int r, int c) { const int st = (r >> 4) * 2 + (c >> 5), rr = r & 15, cc = c & 31, ob = rr * 64 + cc * 2; return st * 1024 + (ob ^ (((ob >> 9) & 1) << 5)); }
__host__ __device__ __forceinline__ void stage_rc(int b, int& R, int& C) { const int st = b / 1024, sb = b % 1024, swz = sb ^ (((sb >> 9) & 1) << 5); R = (st >> 1) * 16 + swz / 64; C = (st & 1) * 32 + (swz % 64) / 2; }
__host__ __device__ __forceinline__ int perm32(int rho) { const int n = rho >> 4, i = rho & 15; return 8 * (i >> 2) + 4 * n + (i & 3); }

struct Unit { int pm, pn; };
struct Gemm { const bf16_t* A; const bf16_t* Bt; int M, N, K; };

struct StaticOrder {
    int nM, nN, nwg, G, c;
    __host__ __device__ void init(int M, int N, int G_, int c_) { nM = M / BM; nN = N / BM; nwg = nM * nN; G = G_; c = c_; }
    __host__ __device__ bool next(int i, Unit& u) const {
        const long L = (long)i * G + c; if (L >= nwg) return false;
        int wgid = (int)L; { const int q = nwg / NXCD, r = nwg % NXCD, xcd = wgid % NXCD, off = wgid / NXCD; wgid = (xcd < r ? xcd * (q + 1) : r * (q + 1) + (xcd - r) * q) + off; }
        const int nig = WGM * nN, gid = wgid / nig, fm = gid * WGM, gsz = (nM - fm) < WGM ? (nM - fm) : WGM;
        u.pm = fm + ((wgid % nig) % gsz); u.pn = (wgid % nig) / gsz; return true;
    }
    __device__ __forceinline__ void a_ready(const Unit&) const {}
    __device__ __forceinline__ void done(const Unit&) const {}
};

typedef float f32x2 __attribute__((ext_vector_type(2)));
template <class Epi, class Sched, bool ALIGN_EPI = false, bool SP2 = false>
__device__ __forceinline__ void gemm_phase(PG8_LAS unsigned char* lds, const Gemm g, const Sched& S, const Epi& E) {
    int tid_ = threadIdx.x; asm volatile("" : "+v"(tid_));
    const int tid = tid_, wid = __builtin_amdgcn_readfirstlane(tid >> 6), lane = tid & 63, wr = wid >> 2, wc = wid & 3, fr = lane & 15, fq = lane >> 4;
    int K_ = g.K; asm volatile("" : "+s"(K_));
    const int K = K_, nt = K / BK;
    unsigned voffA[2], voffB[2];
#pragma unroll
    for (int i = 0; i < 2; ++i) { int R, C; stage_rc(tid * 16 + i * 8192, R, C); const int Rb = Epi::PERM ? ((R & ~31) + perm32(R & 31)) : R;
        voffA[i] = (unsigned)(R * K + C) * 2u; voffB[i] = (unsigned)(Rb * K + C) * 2u; }
    const size_t kstep = (size_t)(BK * 2);
    const size_t hstep = (size_t)HALF * K * 2;
    const size_t tstep = 2 * hstep;
    const unsigned ldsw = (unsigned)wid * 1024u;
    const int aoff = lds_byte(wr * 64 + fr, fq * 8), boff = lds_byte(wc * 32 + fr, fq * 8);
#define PG8_SA(b, h) (((b) * 2 + (h)) * HTB)
#define PG8_SB(b, h) ((4 + (b) * 2 + (h)) * HTB)
#define PG8_STAGE(bufoff, gbase, voff) do { _Pragma("unroll") for (int _i = 0; _i < 2; ++_i) \
        __builtin_amdgcn_global_load_lds((const unsigned*)((const char*)(gbase) + (voff)[_i]), (PG8_LAS unsigned*)(lds + (bufoff) + ldsw + _i * 8192), 16, 0, 0); } while (0)
#define PG8_LDA(dst, b, h) do { _Pragma("unroll") for (int m = 0; m < 4; ++m) _Pragma("unroll") for (int k = 0; k < 2; ++k) dst[m][k] = *(const PG8_LAS bf16x8*)(lds + PG8_SA(b, h) + aoff + m * 2048 + k * 1024); } while (0)
#define PG8_LDB(dst, b, h) do { _Pragma("unroll") for (int n = 0; n < 2; ++n) _Pragma("unroll") for (int k = 0; k < 2; ++k) dst[n][k] = *(const PG8_LAS bf16x8*)(lds + PG8_SB(b, h) + boff + n * 2048 + k * 1024); } while (0)
#define PG8_MMA(ai, bj, At, Bt) do { __builtin_amdgcn_s_setprio(1); _Pragma("unroll") for (int m = 0; m < 4; ++m) _Pragma("unroll") for (int n = 0; n < 2; ++n) _Pragma("unroll") for (int k = 0; k < 2; ++k) \
        acc[ai][bj][m][n] = __builtin_amdgcn_mfma_f32_16x16x32_bf16(Bt[n][k], At[m][k], acc[ai][bj][m][n], 0, 0, 0); __builtin_amdgcn_s_setprio(0); } while (0)
#define PG8_WAIT_V(n) asm volatile("s_waitcnt vmcnt(" #n ")" ::: "memory")
#define PG8_WAIT_L(n) asm volatile("s_waitcnt lgkmcnt(" #n ")" ::: "memory")
#define PG8_BAR __builtin_amdgcn_s_barrier()
#define PG8_SCHED __builtin_amdgcn_sched_barrier(0)
    Unit cur, nxt; int ui = 0;
    if (!S.next(0, cur)) return;
    f32x4 acc[2][2][4][2];
#pragma unroll
    for (int a = 0; a < 2; ++a)
#pragma unroll
        for (int b = 0; b < 2; ++b)
#pragma unroll
            for (int m = 0; m < 4; ++m)
#pragma unroll
                for (int n = 0; n < 2; ++n) acc[a][b][m][n] = (f32x4){0.f, 0.f, 0.f, 0.f};
    bf16x8 At[4][2], B0[2][2], B1[2][2];
    const char* cA = (const char*)g.A + (size_t)cur.pm * tstep; const char* cB = (const char*)g.Bt + (size_t)cur.pn * tstep;
    S.a_ready(cur);
    if constexpr (SP2) {
        PG8_STAGE(PG8_SB(0, 0), cB, voffB); PG8_STAGE(PG8_SB(0, 1), cB + hstep, voffB); PG8_STAGE(PG8_SA(0, 0), cA, voffA); PG8_STAGE(PG8_SA(0, 1), cA + hstep, voffA);
        if (wr == 1) PG8_BAR;
        PG8_WAIT_V(2); PG8_BAR;
        PG8_STAGE(PG8_SB(1, 0), cB + kstep, voffB); PG8_STAGE(PG8_SA(1, 0), cA + kstep, voffA); PG8_STAGE(PG8_SB(1, 1), cB + hstep + kstep, voffB);
        PG8_WAIT_V(6); PG8_BAR;
    } else {
        PG8_STAGE(PG8_SB(0, 0), cB, voffB); PG8_STAGE(PG8_SA(0, 0), cA, voffA); PG8_STAGE(PG8_SB(0, 1), cB + hstep, voffB); PG8_STAGE(PG8_SA(0, 1), cA + hstep, voffA);
        if (wr == 1) PG8_BAR;
        PG8_WAIT_V(4); PG8_BAR;
        PG8_STAGE(PG8_SB(1, 0), cB + kstep, voffB); PG8_STAGE(PG8_SA(1, 0), cA + kstep, voffA); PG8_STAGE(PG8_SB(1, 1), cB + hstep + kstep, voffB);
        PG8_WAIT_V(6); PG8_BAR;
    }
    for (;;) {
        const bool has_next = S.next(ui + 1, nxt);
        const char* nA = has_next ? (const char*)g.A + (size_t)nxt.pm * tstep : cA; const char* nB = has_next ? (const char*)g.Bt + (size_t)nxt.pn * tstep : cB;
        for (int t = 0; t < nt; t += 2) {
            const bool last = (t == nt - 2);
            const char* a1 = cA + (size_t)(t + 1) * kstep;
            const char* a2 = last ? nA : cA + (size_t)(t + 2) * kstep; const char* b2 = last ? nB : cB + (size_t)(t + 2) * kstep;
            const char* a3 = a2 + kstep; const char* b3 = b2 + kstep;
            if (last && has_next) S.a_ready(nxt);
            if constexpr (SP2) {
            PG8_LDB(B0, 0, 0); PG8_LDB(B1, 0, 1); PG8_SCHED; PG8_LDA(At, 0, 0); PG8_STAGE(PG8_SA(1, 1), a1 + hstep, voffA);
            PG8_WAIT_V(8); PG8_WAIT_L(0); PG8_BAR; PG8_MMA(0, 0, At, B0); PG8_MMA(0, 1, At, B1); PG8_BAR; PG8_SCHED;
            PG8_LDA(At, 0, 1); PG8_STAGE(PG8_SB(0, 0), b2, voffB); PG8_STAGE(PG8_SB(0, 1), b2 + hstep, voffB); PG8_STAGE(PG8_SA(0, 0), a2, voffA);
            PG8_WAIT_V(8); PG8_WAIT_L(0); PG8_BAR; PG8_MMA(1, 0, At, B0); PG8_MMA(1, 1, At, B1); PG8_BAR; PG8_SCHED;
            PG8_LDB(B0, 1, 0); PG8_LDB(B1, 1, 1); PG8_SCHED; PG8_LDA(At, 1, 0); PG8_STAGE(PG8_SA(0, 1), a2 + hstep, voffA);
            PG8_WAIT_V(8); PG8_WAIT_L(0); PG8_BAR; PG8_MMA(0, 0, At, B0); PG8_MMA(0, 1, At, B1); PG8_BAR; PG8_SCHED;
            PG8_LDA(At, 1, 1); PG8_STAGE(PG8_SB(1, 0), b3, voffB); PG8_STAGE(PG8_SB(1, 1), b3 + hstep, voffB); PG8_STAGE(PG8_SA(1, 0), a3, voffA);
            PG8_WAIT_V(8); PG8_WAIT_L(0); PG8_BAR; PG8_MMA(1, 0, At, B0); PG8_MMA(1, 1, At, B1); PG8_BAR; PG8_SCHED;
            } else {
            PG8_LDB(B0, 0, 0); PG8_SCHED; PG8_LDA(At, 0, 0); PG8_STAGE(PG8_SA(1, 1), a1 + hstep, voffA);
            PG8_WAIT_L(8); PG8_BAR; PG8_WAIT_L(0); PG8_MMA(0, 0, At, B0); PG8_BAR; PG8_SCHED;
            PG8_LDB(B1, 0, 1); PG8_STAGE(PG8_SB(0, 0), b2, voffB);
            PG8_BAR; PG8_WAIT_L(0); PG8_MMA(0, 1, At, B1); PG8_BAR;
            PG8_LDA(At, 0, 1); PG8_STAGE(PG8_SA(0, 0), a2, voffA);
            PG8_BAR; PG8_WAIT_L(0); PG8_MMA(1, 0, At, B0); PG8_BAR; PG8_SCHED;
            PG8_STAGE(PG8_SB(0, 1), b2 + hstep, voffB);
            PG8_WAIT_V(6); PG8_BAR; PG8_MMA(1, 1, At, B1); PG8_BAR;
            PG8_LDB(B0, 1, 0); PG8_SCHED; PG8_LDA(At, 1, 0); PG8_STAGE(PG8_SA(0, 1), a2 + hstep, voffA);
            PG8_WAIT_L(8); PG8_BAR; PG8_WAIT_L(0); PG8_MMA(0, 0, At, B0); PG8_BAR; PG8_SCHED;
            PG8_LDB(B1, 1, 1); PG8_STAGE(PG8_SB(1, 0), b3, voffB);
            PG8_BAR; PG8_WAIT_L(0); PG8_MMA(0, 1, At, B1); PG8_BAR;
            PG8_LDA(At, 1, 1); PG8_STAGE(PG8_SA(1, 0), a3, voffA);
            PG8_BAR; PG8_WAIT_L(0); PG8_MMA(1, 0, At, B0); PG8_BAR; PG8_SCHED;
            PG8_STAGE(PG8_SB(1, 1), b3 + hstep, voffB);
            PG8_WAIT_V(6); PG8_BAR; PG8_MMA(1, 1, At, B1); PG8_BAR;
            }
        }
        if constexpr (ALIGN_EPI) { if (wr == 0) PG8_BAR; }
        if constexpr (!Epi::AFTER_DRAIN) { E(acc, cur, wr, wc, fr, fq); S.done(cur); }
        if (!has_next) break;
#pragma unroll
        for (int a = 0; a < 2; ++a)
#pragma unroll
            for (int b = 0; b < 2; ++b)
#pragma unroll
                for (int m = 0; m < 4; ++m)
#pragma unroll
                    for (int n = 0; n < 2; ++n) acc[a][b][m][n] = (f32x4){0.f, 0.f, 0.f, 0.f};
        cur = nxt; cA = nA; cB = nB; ++ui;
        if constexpr (ALIGN_EPI) { if (wr == 1) PG8_BAR; }
    }
    PG8_WAIT_V(0);
    if constexpr (!ALIGN_EPI) { if (wr == 0) PG8_BAR; }
    PG8_BAR;
    if constexpr (Epi::AFTER_DRAIN) { E.fused(acc, cur, wr, wc, fr, fq, lds, wid, lane); S.done(cur); }
#undef PG8_SA
#undef PG8_SB
#undef PG8_STAGE
#undef PG8_LDA
#undef PG8_LDB
#undef PG8_MMA
#undef PG8_WAIT_V
#undef PG8_WAIT_L
#undef PG8_BAR
#undef PG8_SCHED
}
}

using pg8::bf16_t; using pg8::f32x4; using pg8::u32x4; using pg8::Unit;
#define LAS __attribute__((address_space(3)))
constexpr int DM = 1024, NH = 8, PLE = 256, INC = 3072;
constexpr int BP = 16, SP = 4096, BS = 8, SS = 2048;
constexpr int MP = BP * SP, MS = BS * SS, MT = MP + MS;
constexpr float EPS = 1e-6f, LOG2E = 1.4426950408889634f;
constexpr float LAM_INIT = 0.2f;
constexpr int NWAVES = 8, NTHREADS = 512;
constexpr int LDS_BYTES = 147456;

constexpr size_t MiB = 1u << 20;
constexpr size_t WS_CTL = 0, CTL_ZERO_BYTES = 1 * MiB;
constexpr int CW_QUEUE = 1024;
constexpr int CW_PANEL = 32768;
constexpr int CW_PLEQ = 20480;
constexpr int CW_PB = 24576;
constexpr int CW_PREP = 16384;
constexpr int CW_BAR = 4096;
constexpr int MISC_OFF = LDS_BYTES - 1024;
constexpr size_t WS_WIN = 2 * MiB, WS_WOUT = 8 * MiB, WS_WPG = 10 * MiB, WS_WPLE = 12 * MiB, WS_MISC = 14 * MiB;
constexpr size_t WS_XN = 16 * MiB;
constexpr size_t WS_MIX = WS_XN;
constexpr size_t WS_Q = 176 * MiB, WS_K = 256 * MiB, WS_V = 336 * MiB, WS_GA = 416 * MiB, WS_XR = 496 * MiB, WS_GL = 576 * MiB;
constexpr size_t WS_PB = 656 * MiB;
constexpr size_t WS_HSF = 696 * MiB;
constexpr size_t WS_HSB = 856 * MiB;
constexpr size_t WS_HB = WS_Q;
constexpr size_t WS_PW = WS_XR;
constexpr size_t WS_END = 1016 * MiB;

__device__ __forceinline__ unsigned f2bf(float f) { unsigned u = __builtin_bit_cast(unsigned, f); return (u + 0x7fffu + ((u >> 16) & 1u)) >> 16; }
__device__ __forceinline__ float bf2f(unsigned h) { return __builtin_bit_cast(float, h << 16); }
__device__ __forceinline__ float fast_sigmoid(float x) { return __builtin_amdgcn_rcpf(1.f + __builtin_amdgcn_exp2f(-LOG2E * x)); }
typedef float f32x2_t __attribute__((ext_vector_type(2))); typedef __bf16 bf16x2_t __attribute__((ext_vector_type(2)));
__device__ __forceinline__ unsigned pk2(float lo, float hi) { f32x2_t v = {lo, hi}; bf16x2_t b = __builtin_convertvector(v, bf16x2_t); return __builtin_bit_cast(unsigned, b); }

struct Ptrs {
    const float *xp, *xs, *pp, *ps, *g_norm, *w_in, *q_norm, *k_norm, *lq1, *lk1, *lq2, *lk2, *sub_norm, *rel_bias, *conv_w, *conv_b, *w_a, *b_a, *w_x, *b_x, *lam, *w_out, *w_ple, *w_pg, *g_ple;
    float* out; unsigned char* ws;
};
__device__ __forceinline__ const float* xrow(const Ptrs& P, int m) { return m < MP ? P.xp + (size_t)m * DM : P.xs + (size_t)(m - MP) * DM; }
__device__ __forceinline__ const float* prow(const Ptrs& P, int m) { return m < MP ? P.pp + (size_t)m * PLE : P.ps + (size_t)(m - MP) * PLE; }

struct EpiIn {
    static constexpr bool PERM = true, AFTER_DRAIN = false;
    unsigned char* ws; const float* qn; const float* kn;
    __device__ __forceinline__ void operator()(const f32x4 (&acc)[2][2][4][2], const Unit& u, int wr, int wc, int fr, int fq) const {
        const int t = u.pn >> 1;
        bf16_t* O = (bf16_t*)(ws + WS_Q + (size_t)t * (80 * MiB));
        const int row0 = u.pm * 256 + wr * 64 + fr, col0 = (u.pn & 1) * 256 + wc * 32 + 8 * fq;
        f32x4 g0 = {1.f, 1.f, 1.f, 1.f}, g1 = g0;
        if (t < 2) { const float* gp = (t == 0 ? qn : kn) + 8 * fq; g0 = *(const f32x4*)gp; g1 = *(const f32x4*)(gp + 4); if (t == 0) { g0 = g0 * (0.17677669529663687f * LOG2E); g1 = g1 * (0.17677669529663687f * LOG2E); } }
#pragma unroll
        for (int ai = 0; ai < 2; ++ai)
#pragma unroll
            for (int m = 0; m < 4; ++m) { bf16_t* rowp = O + (size_t)(row0 + ai * 128 + m * 16) * 512 + col0;
#pragma unroll
                for (int bj = 0; bj < 2; ++bj) { f32x4 v0 = acc[ai][bj][m][0], v1 = acc[ai][bj][m][1];
                    if (t < 2) { float ss = (v0[0]*v0[0] + v0[1]*v0[1]) + (v0[2]*v0[2] + v0[3]*v0[3]) + (v1[0]*v1[0] + v1[1]*v1[1]) + (v1[2]*v1[2] + v1[3]*v1[3]);
                        ss += __shfl_xor(ss, 16); ss += __shfl_xor(ss, 32); const float rs = __builtin_amdgcn_rsqf(ss * (1.f / 32.f) + EPS); v0 = v0 * rs * g0; v1 = v1 * rs * g1; }
                    else if (t == 3 || t == 5) {
#pragma unroll
                        for (int j = 0; j < 4; ++j) { v0[j] = v0[j] * fast_sigmoid(v0[j]); v1[j] = v1[j] * fast_sigmoid(v1[j]); } }
                    u32x4 w; w.x = pk2(v0[0], v0[1]); w.y = pk2(v0[2], v0[3]); w.z = pk2(v1[0], v1[1]); w.w = pk2(v1[2], v1[3]);
                    *(u32x4*)(rowp + bj * 128) = w; } }
    }
};
struct EpiOut {
    static constexpr bool PERM = true, AFTER_DRAIN = false;
    const float* xp; const float* xs; float* out; bf16_t* hb;
    __device__ __forceinline__ void operator()(const f32x4 (&acc)[2][2][4][2], const Unit& u, int wr, int wc, int fr, int fq) const {
        const int row0 = u.pm * 256 + wr * 64 + fr, col0 = u.pn * 256 + wc * 32 + 8 * fq;
        const float* xb = (u.pm * 256 < MP) ? xp : xs - (size_t)MP * DM;
#pragma unroll
        for (int ai = 0; ai < 2; ++ai)
#pragma unroll
            for (int m = 0; m < 4; ++m) { const size_t off = (size_t)(row0 + ai * 128 + m * 16) * DM + col0;
#pragma unroll
                for (int bj = 0; bj < 2; ++bj) { const f32x4 x0 = *(const f32x4*)(xb + off + bj * 128), x1 = *(const f32x4*)(xb + off + bj * 128 + 4);
                    const f32x4 v0 = acc[ai][bj][m][0] + x0, v1 = acc[ai][bj][m][1] + x1;
                    u32x4 w; w.x = pk2(v0[0], v0[1]); w.y = pk2(v0[2], v0[3]); w.z = pk2(v1[0], v1[1]); w.w = pk2(v1[2], v1[3]);
                    *(u32x4*)(hb + off + bj * 128) = w; } }
    }
};
struct EpiStore {
    static constexpr bool PERM = true, AFTER_DRAIN = false;
    bf16_t* o;
    __device__ __forceinline__ void operator()(const f32x4 (&acc)[2][2][4][2], const Unit& u, int wr, int wc, int fr, int fq) const {
        const int row0 = u.pm * 256 + wr * 64 + fr, col0 = u.pn * 256 + wc * 32 + 8 * fq;
#pragma unroll
        for (int ai = 0; ai < 2; ++ai)
#pragma unroll
            for (int m = 0; m < 4; ++m) { const size_t off = (size_t)(row0 + ai * 128 + m * 16) * DM + col0;
#pragma unroll
                for (int bj = 0; bj < 2; ++bj) { const f32x4 v0 = acc[ai][bj][m][0], v1 = acc[ai][bj][m][1];
                    u32x4 w; w.x = pk2(v0[0], v0[1]); w.y = pk2(v0[2], v0[3]); w.z = pk2(v1[0], v1[1]); w.w = pk2(v1[2], v1[3]);
                    *(u32x4*)(o + off + bj * 128) = w; } }
    }
};
struct EpiGateFinal {
    static constexpr bool PERM = true, AFTER_DRAIN = false;
    const bf16_t* pw; const bf16_t* hb; float* out; const float* gp; float* slots; unsigned* cnt;
    __device__ __forceinline__ void operator()(f32x4 (&acc)[2][2][4][2], const Unit& u, int wr, int wc, int fr, int fq) const {
        const int row0 = u.pm * 256 + wr * 64 + fr, col0 = u.pn * 256 + wc * 32 + 8 * fq;
        float ss[2][4];
#pragma unroll
        for (int ai = 0; ai < 2; ++ai)
#pragma unroll
            for (int m = 0; m < 4; ++m) { const size_t off = (size_t)(row0 + ai * 128 + m * 16) * DM + col0; float q = 0.f;
#pragma unroll
                for (int bj = 0; bj < 2; ++bj) { const u32x4 s = *(const u32x4*)(pw + off + bj * 128); f32x4 v0 = acc[ai][bj][m][0], v1 = acc[ai][bj][m][1];
#pragma unroll
                    for (int j = 0; j < 4; ++j) { v0[j] = fast_sigmoid(v0[j]); v1[j] = fast_sigmoid(v1[j]); }
                    v0[0] *= bf2f(s.x & 0xffff); v0[1] *= bf2f(s.x >> 16); v0[2] *= bf2f(s.y & 0xffff); v0[3] *= bf2f(s.y >> 16);
                    v1[0] *= bf2f(s.z & 0xffff); v1[1] *= bf2f(s.z >> 16); v1[2] *= bf2f(s.w & 0xffff); v1[3] *= bf2f(s.w >> 16);
                    acc[ai][bj][m][0] = v0; acc[ai][bj][m][1] = v1;
                    q += (v0[0]*v0[0] + v0[1]*v0[1]) + (v0[2]*v0[2] + v0[3]*v0[3]) + (v1[0]*v1[0] + v1[1]*v1[1]) + (v1[2]*v1[2] + v1[3]*v1[3]); }
                q += __shfl_xor(q, 16); q += __shfl_xor(q, 32); ss[ai][m] = q; asm volatile("" ::: "memory"); }
        if (fq == 0) {
#pragma unroll
            for (int ai = 0; ai < 2; ++ai)
#pragma unroll
                for (int m = 0; m < 4; ++m) __hip_atomic_store(slots + (size_t)(row0 + ai * 128 + m * 16) * 16 + u.pn * 4 + wc, ss[ai][m], __ATOMIC_RELAXED, __HIP_MEMORY_SCOPE_AGENT);
        }
        asm volatile("s_waitcnt vmcnt(0)" ::: "memory");
        unsigned* c = cnt + 64 * u.pm;
        if ((threadIdx.x & 63) == 0) __hip_atomic_fetch_add(c, 1u, __ATOMIC_RELAXED, __HIP_MEMORY_SCOPE_AGENT);
        { unsigned sp = 0; while (__hip_atomic_load(c, __ATOMIC_RELAXED, __HIP_MEMORY_SCOPE_AGENT) < 32u) { __builtin_amdgcn_s_sleep(2); if (++sp > (1u << 22)) break; } }
        const f32x4 g00 = *(const f32x4*)(gp + col0), g01 = *(const f32x4*)(gp + col0 + 4), g10 = *(const f32x4*)(gp + col0 + 128), g11 = *(const f32x4*)(gp + col0 + 132);
#pragma unroll
        for (int ai = 0; ai < 2; ++ai)
#pragma unroll
            for (int m = 0; m < 4; ++m) { const size_t row = (size_t)(row0 + ai * 128 + m * 16); const size_t off = row * DM + col0;
                const unsigned long long* sl = (const unsigned long long*)(slots + row * 16 + fq * 4);
                const unsigned long long p0 = __hip_atomic_load(sl, __ATOMIC_RELAXED, __HIP_MEMORY_SCOPE_AGENT), p1 = __hip_atomic_load(sl + 1, __ATOMIC_RELAXED, __HIP_MEMORY_SCOPE_AGENT);
                float t = (__uint_as_float((unsigned)p0) + __uint_as_float((unsigned)(p0 >> 32))) + (__uint_as_float((unsigned)p1) + __uint_as_float((unsigned)(p1 >> 32)));
                t += __shfl_xor(t, 16); t += __shfl_xor(t, 32);
                const float rs = rsqrtf(t * (1.f / DM) + EPS);
#pragma unroll
                for (int bj = 0; bj < 2; ++bj) { const u32x4 hv = *(const u32x4*)(hb + off + bj * 128); const f32x4 ga = bj ? g10 : g00, gb = bj ? g11 : g01; const f32x4 v0 = acc[ai][bj][m][0], v1 = acc[ai][bj][m][1]; f32x4 o0, o1;
                    o0[0] = bf2f(hv.x & 0xffff) + v0[0] * rs * ga[0]; o0[1] = bf2f(hv.x >> 16) + v0[1] * rs * ga[1]; o0[2] = bf2f(hv.y & 0xffff) + v0[2] * rs * ga[2]; o0[3] = bf2f(hv.y >> 16) + v0[3] * rs * ga[3];
                    o1[0] = bf2f(hv.z & 0xffff) + v1[0] * rs * gb[0]; o1[1] = bf2f(hv.z >> 16) + v1[1] * rs * gb[1]; o1[2] = bf2f(hv.w & 0xffff) + v1[2] * rs * gb[2]; o1[3] = bf2f(hv.w >> 16) + v1[3] * rs * gb[3];
                    *(f32x4*)(out + off + bj * 128) = o0; *(f32x4*)(out + off + bj * 128 + 4) = o1; }
                asm volatile("" ::: "memory"); }
    }
};

__device__ __forceinline__ void p0_transpose_item(const float* W, int K, int N, bf16_t* WT, LAS float* scr, int item, int lane) {
    const int nblk = N / 32, kb = item / nblk, nb = item % nblk, k0 = 64 * kb, n0 = 32 * nb;
#pragma unroll 8
    for (int i = 0; i < 32; ++i) { const int kk = 2 * i + (lane >> 5); scr[kk * 33 + (lane & 31)] = W[(size_t)(k0 + kk) * N + n0 + (lane & 31)]; }
    asm volatile("s_waitcnt lgkmcnt(0)" ::: "memory");
    const int c = lane & 7;
#pragma unroll
    for (int j = 0; j < 4; ++j) { const int n = (lane >> 3) + 8 * j; const LAS float* s = scr + (8 * c) * 33 + n;
        u32x4 o; o.x = pk2(s[0 * 33], s[1 * 33]); o.y = pk2(s[2 * 33], s[3 * 33]); o.z = pk2(s[4 * 33], s[5 * 33]); o.w = pk2(s[6 * 33], s[7 * 33]);
        *(u32x4*)(WT + (size_t)(n0 + n) * K + k0 + 8 * c) = o; }
    asm volatile("s_waitcnt lgkmcnt(0)" ::: "memory");
}
__device__ __forceinline__ void prep_rows64(const Ptrs& P, int rb, int wave, int lane, unsigned* cnt) {
#pragma unroll 1
    for (int k = 0; k < 2; ++k) {
        const int m0 = rb + wave * 8 + 4 * k; f32x4 v[4][4]; float ss[4];
#pragma unroll
        for (int q = 0; q < 4; ++q) { const float* xq = xrow(P, m0 + q);
#pragma unroll
            for (int j = 0; j < 4; ++j) v[q][j] = *(const f32x4*)(xq + j * 256 + lane * 4); }
#pragma unroll
        for (int q = 0; q < 4; ++q) { float t = 0.f;
#pragma unroll
            for (int j = 0; j < 4; ++j) t += (v[q][j][0]*v[q][j][0] + v[q][j][1]*v[q][j][1]) + (v[q][j][2]*v[q][j][2] + v[q][j][3]*v[q][j][3]);
            ss[q] = t; }
#pragma unroll
        for (int o = 1; o < 64; o <<= 1) {
#pragma unroll
            for (int q = 0; q < 4; ++q) ss[q] += __shfl_xor(ss[q], o); }
#pragma unroll
        for (int j = 0; j < 4; ++j) { const int c = j * 256 + lane * 4; const f32x4 g = *(const f32x4*)(P.g_norm + c);
#pragma unroll
            for (int q = 0; q < 4; ++q) { const float rq = rsqrtf(ss[q] * (1.f / DM) + EPS); const f32x4 y = v[q][j] * rq * g;
                __hip_atomic_store((unsigned long long*)((bf16_t*)(P.ws + WS_XN) + (size_t)(m0 + q) * DM + c), (unsigned long long)pk2(y[0], y[1]) | ((unsigned long long)pk2(y[2], y[3]) << 32), __ATOMIC_RELAXED, __HIP_MEMORY_SCOPE_AGENT); } }
    }
    asm volatile("s_waitcnt vmcnt(0)" ::: "memory");
    if (lane == 0) __hip_atomic_fetch_add(cnt, 1u, __ATOMIC_RELAXED, __HIP_MEMORY_SCOPE_AGENT);
}
__device__ __forceinline__ void p0_prep(const Ptrs& P, LAS unsigned char* lds, int wave, int lane) {
    LAS float* scr = (LAS float*)(lds + wave * 16384);
    const int gw = blockIdx.x * NWAVES + wave, NGW = gridDim.x * NWAVES;
    constexpr int I_IN = (1024 / 64) * (INC / 32), I_SQ = (1024 / 64) * (1024 / 32), I_PLE = (256 / 64) * (1024 / 32);
    for (int it = gw; it < I_IN + 2 * I_SQ + I_PLE; it += NGW) {
        int r = it;
        if (r < I_IN) { p0_transpose_item(P.w_in, 1024, INC, (bf16_t*)(P.ws + WS_WIN), scr, r, lane); continue; } r -= I_IN;
        if (r < I_SQ) { p0_transpose_item(P.w_out, 1024, 1024, (bf16_t*)(P.ws + WS_WOUT), scr, r, lane); continue; } r -= I_SQ;
        if (r < I_SQ) { p0_transpose_item(P.w_pg, 1024, 1024, (bf16_t*)(P.ws + WS_WPG), scr, r, lane); continue; } r -= I_SQ;
        p0_transpose_item(P.w_ple, 256, 1024, (bf16_t*)(P.ws + WS_WPLE), scr, r, lane);
    }
    if (gw == 0 && lane == 0) { float s1 = 0.f, s2 = 0.f; for (int i = 0; i < 32; ++i) { s1 += P.lq1[i] * P.lk1[i]; s2 += P.lq2[i] * P.lk2[i]; }
        *(float*)(P.ws + WS_MISC) = __expf(s1) - __expf(s2) + LAM_INIT; }
    prep_rows64(P, (int)(blockIdx.x & 7u) * 5 * 2048 + (int)(blockIdx.x >> 3) * 64, wave, lane, (unsigned*)(P.ws + WS_CTL) + CW_PREP + (int)(blockIdx.x & 7u) * 5 * 64);
}
struct InProjOrder : pg8::StaticOrder {
    const Ptrs* P; unsigned* cnt; int wave, lane, xcd, slot; mutable int ready_gid;
    __device__ __forceinline__ bool next(int i, pg8::Unit& u) const {
        if (i >= 1 && i <= 12 && (i - 1) % 3 == slot % 3) { const int gid = xcd * 5 + (i - 1) / 3 + 1; prep_rows64(*P, gid * 2048 + slot * 64, wave, lane, cnt + gid * 64); }
        return pg8::StaticOrder::next(i, u);
    }
    __device__ __forceinline__ void a_ready(const pg8::Unit& u) const {
        const int gid = u.pm >> 3;
        if (gid != ready_gid) { while (__hip_atomic_load(cnt + gid * 64, __ATOMIC_RELAXED, __HIP_MEMORY_SCOPE_AGENT) < 256u) __builtin_amdgcn_s_sleep(4); ready_gid = gid; }
    }
};
__device__ __forceinline__ void pb_item(const Ptrs& P, int panel, int wave, int lane) {
    const int base = panel * 256;
    for (int r = wave; r < 64; r += 8) {
        f32x4 t[4];
#pragma unroll
        for (int k = 0; k < 4; ++k) t[k] = *(const f32x4*)(prow(P, base + r + 64 * k) + lane * 4);
#pragma unroll
        for (int k = 0; k < 4; ++k) __hip_atomic_store((unsigned long long*)((bf16_t*)(P.ws + WS_PB) + (size_t)(base + r + 64 * k) * PLE + lane * 4), (unsigned long long)pk2(t[k][0], t[k][1]) | ((unsigned long long)pk2(t[k][2], t[k][3]) << 32), __ATOMIC_RELAXED, __HIP_MEMORY_SCOPE_AGENT);
    }
    asm volatile("s_waitcnt vmcnt(0)" ::: "memory");
    if (lane == 0) __hip_atomic_fetch_add((unsigned*)(P.ws + WS_CTL) + CW_PB + panel * 16, 1u, __ATOMIC_RELAXED, __HIP_MEMORY_SCOPE_AGENT);
}
struct PleOrder { unsigned* q; unsigned* pbc; volatile LAS unsigned* slots; int tid; mutable unsigned pend; mutable int ready_pm;
    __device__ __forceinline__ bool next(int i, pg8::Unit& u) const {
        if (tid == 0) { slots[(i + 1) & 3] = pend; pend = __hip_atomic_fetch_add(q, 1u, __ATOMIC_RELAXED, __HIP_MEMORY_SCOPE_AGENT); asm volatile("s_waitcnt lgkmcnt(0)" ::: "memory"); }
        const unsigned v = (unsigned)__builtin_amdgcn_readfirstlane((int)slots[i & 3]);
        if (v >= 1280u) return false;
        u.pm = (int)(v >> 5) * 8 + (int)(v & 7u); u.pn = (int)(v & 31u) >> 3; return true;
    }
    __device__ __forceinline__ void a_ready(const pg8::Unit& u) const {
        if (u.pm != ready_pm) { while (__hip_atomic_load(pbc + u.pm * 16, __ATOMIC_RELAXED, __HIP_MEMORY_SCOPE_AGENT) < 8u) __builtin_amdgcn_s_sleep(2); ready_pm = u.pm; }
    }
    __device__ __forceinline__ void done(const pg8::Unit&) const {}
};
struct Deq { unsigned* qctl; unsigned xcc; volatile LAS unsigned* misc;
    __device__ __forceinline__ void operator()() const { int item = -1, q = (int)misc[17];
        while (q < 8) { const unsigned x = (xcc + (unsigned)q) & 7u; const unsigned j = __hip_atomic_fetch_add(qctl + 64 * x, 1u, __ATOMIC_RELAXED, __HIP_MEMORY_SCOPE_AGENT); if (j < 384u) { item = (int)(x * 1024u + j); break; } ++q; }
        misc[16] = (unsigned)item; misc[17] = (unsigned)q; } };
namespace att {
typedef short bf16x8 __attribute__((ext_vector_type(8)));
typedef short s16x4 __attribute__((ext_vector_type(4)));
typedef float f32x16 __attribute__((ext_vector_type(16)));
typedef short v4i16_t __attribute__((ext_vector_type(4)));
constexpr int SLOT = 8192;
__device__ __forceinline__ int crow(int r, int hi) { return (r & 3) + 8 * (r >> 2) + 4 * hi; }
__device__ __forceinline__ int t5_bucket(int rel) { const int n = rel < 0 ? -rel : rel; int v = n; if (n >= 8) { v = 2 + (31 - __clz(n * n)); v = v > 15 ? 15 : v; } return (rel > 0 ? 16 : 0) + v; }
__device__ __forceinline__ s16x4 vtr(const LAS unsigned char* p) { return __builtin_bit_cast(s16x4, __builtin_amdgcn_ds_read_tr16_b64_v4i16((LAS v4i16_t*)p)); }
#define ATT_MFMA(a, b, c) __builtin_amdgcn_mfma_f32_32x32x16_bf16(a, b, c, 0, 0, 0)

#define SBAR() __builtin_amdgcn_sched_barrier(0)
#define PIN(x) asm volatile("" : "+v"(x))
#define WAIT_BAR(N) asm volatile("s_waitcnt vmcnt(" #N ") lgkmcnt(0)\n\ts_barrier" ::: "memory")
__device__ __forceinline__ void glds16(const void* g, unsigned lds_base) {
    asm volatile("s_mov_b32 m0, %1\n\ts_nop 0\n\tglobal_load_lds_dwordx4 %0, off" :: "v"(g), "s"(lds_base) : "memory", "m0"); }
constexpr int KSLOTS = 4, K2OFF = 0, V2OFF = KSLOTS * SLOT, DLT2_OFF = V2OFF + 4 * SLOT, WSF2_OFF = DLT2_OFF + 2048, STG2_OFF = WSF2_OFF + 2048;
static_assert(STG2_OFF + 8 * SLOT <= MISC_OFF, "attention LDS");
__device__ __forceinline__ void attn_unit(LAS unsigned char* lds, const Ptrs& P, const float lam, const int S, const size_t rowbase, const int h, const int qb, const Deq& nx) {
    int tid_ = threadIdx.x; asm volatile("" : "+v"(tid_));
    const int tid = tid_, lane = tid & 63, r32 = lane & 31, hi = lane >> 5; const int wid = __builtin_amdgcn_readfirstlane(tid >> 6);
    const int qw = qb * 256 + wid * 32;
    const bf16_t* Qg = (const bf16_t*)(P.ws + WS_Q) + (rowbase + qw) * 512 + h * 64;
    const bf16_t* Kg = (const bf16_t*)(P.ws + WS_K) + rowbase * 512 + h * 64;
    const bf16_t* Vg = (const bf16_t*)(P.ws + WS_V) + rowbase * 512 + h * 64;
    LAS float* dlt = (LAS float*)(lds + DLT2_OFF); LAS float* wsf = (LAS float*)(lds + WSF2_OFF) + wid * 64; LAS float* stg = (LAS float*)(lds + STG2_OFF) + wid * 2048;
    const unsigned lds0 = (unsigned)(uintptr_t)lds;
    const float c_lo = P.rel_bias[15 * NH + h] * LOG2E, c_hi = P.rel_bias[31 * NH + h] * LOG2E;
    const float hi_scale = exp2f(c_lo - c_hi);
    const int NT = S / 64;
    const bf16_t* ksrc = Kg + (size_t)lane * 512 + wid * 8;
    const bf16_t* vsrc = Vg + (size_t)(16 * (wid & 3) + (lane >> 2)) * 512 + (wid >> 2) * 32 + (lane & 3) * 8;
    const unsigned kdst = lds0 + K2OFF + wid * 1024, vdst = lds0 + V2OFF + wid * 1024;
#define DMA_K(t, slot) glds16(ksrc + (size_t)((t) < NT ? (t) : NT - 1) * 64 * 512, (unsigned)__builtin_amdgcn_readfirstlane(kdst + (slot)))
#define DMA_V(t, slot) glds16(vsrc + (size_t)((t) < NT ? (t) : NT - 1) * 64 * 512, (unsigned)__builtin_amdgcn_readfirstlane(vdst + (slot)))
    dlt[tid] = P.rel_bias[t5_bucket(tid - 256) * NH + h] * LOG2E - c_lo;
    DMA_K(0, 0); DMA_V(0, 0); DMA_K(1, SLOT); DMA_V(1, SLOT); DMA_K(2, 2 * SLOT); DMA_V(2, 2 * SLOT);
    bf16x8 qr[4];
#pragma unroll
    for (int d0 = 0; d0 < 4; ++d0) qr[d0] = *(const bf16x8*)(Qg + (size_t)r32 * 512 + d0 * 16 + hi * 8);
    f32x16 o00, o01, o10, o11, X0, X1, Y0, Y1;
#pragma unroll
    for (int r = 0; r < 16; ++r) { o00[r] = 0.f; o01[r] = 0.f; o10[r] = 0.f; o11[r] = 0.f; Y0[r] = 0.f; Y1[r] = 0.f; }
    float l0 = 0.f, l0b = 0.f, l1 = 0.f, l1b = 0.f; bool in_hi = false;
    s16x4 vlo[8], vhi[8]; u32x4 pw0, pw1, pw2, pw3; bf16x8 kfa[4], kfb[4];
#pragma unroll
    for (int i = 0; i < 8; ++i) { vlo[i] = (s16x4){0, 0, 0, 0}; vhi[i] = (s16x4){0, 0, 0, 0}; }
    unsigned ones2 = 0x3f803f80u; asm volatile("" : "+s"(ones2));
    f32x16 zero16;
#pragma unroll
    for (int r = 0; r < 16; ++r) zero16[r] = 0.f;
    const LAS unsigned char* kp0 = lds + K2OFF + hi * 1024 + r32 * 16;
    const LAS unsigned char* vp0 = lds + V2OFF + ((lane >> 4) & 1) * 32 + (lane & 3) * 8 + (4 * hi + ((lane & 15) >> 2)) * 64;
    __builtin_amdgcn_s_waitcnt(0x0F70);
    WAIT_BAR(1);
#pragma unroll
    for (int i = 0; i < 4; ++i) kfa[i] = *(const LAS bf16x8*)(kp0 + (i >> 1) * 2048 + (i & 1) * 512);
#define KLD(kf, base, c, i) kf[i] = *(const LAS bf16x8*)((base) + (2 * (c) + ((i) >> 1)) * 2048 + ((i) & 1) * 512)
#define VRD(i, vb) do { vlo[i] = vtr((vb) + (((i) >> 2) * 4096 + ((i) & 3) * 1024)); vhi[i] = vtr((vb) + (((i) >> 2) * 4096 + ((i) & 3) * 1024 + 512)); } while (0)
#define VFR(i) (bf16x8){vlo[i][0], vlo[i][1], vlo[i][2], vlo[i][3], vhi[i][0], vhi[i][1], vhi[i][2], vhi[i][3]}
#define PAF(k) __builtin_bit_cast(bf16x8, pw##k)
#define DOT1(acc, w) acc = __builtin_amdgcn_fdot2_f32_bf16(__builtin_bit_cast(bf16x2_t, (w)), __builtin_bit_cast(bf16x2_t, ones2), acc, false)
#define GAPA(MF, Pv, B, PW, sacc, saccb) do { MF; unsigned w0_ = pk2(Pv[B], Pv[B + 1]), w1_ = pk2(Pv[B + 2], Pv[B + 3]), w2_ = pk2(Pv[B + 4], Pv[B + 5]), w3_ = pk2(Pv[B + 6], Pv[B + 7]); \
        PIN(w0_); PIN(w1_); PIN(w2_); PIN(w3_); DOT1(sacc, w0_); DOT1(saccb, w1_); DOT1(sacc, w2_); DOT1(saccb, w3_); PW = (u32x4){w0_, w1_, w2_, w3_}; PIN(sacc); PIN(saccb); SBAR(); } while (0)
#define EX(v) __builtin_amdgcn_exp2f(v)
#define GAPB(MF, Xv, B) do { MF; Xv[B] = EX(Xv[B]); Xv[B + 1] = EX(Xv[B + 1]); Xv[B + 2] = EX(Xv[B + 2]); Xv[B + 3] = EX(Xv[B + 3]); PIN(Xv); SBAR(); } while (0)
#define NEARADD(A0, A1) do { if (near) { const int ib = k0 - (qw + r32) + 256 + 4 * hi; \
        _Pragma("unroll") for (int r = 0; r < 16; ++r) { const int ix = ib + (r & 3) + 8 * (r >> 2); A0[r] += dlt[ix]; A1[r] += dlt[ix + 32]; } } } while (0)
    if (wid >= 4) __builtin_amdgcn_s_setprio(1);
    for (int t = 0; t < NT; ++t) {
        const int k0 = t * 64;
        const LAS unsigned char* kpc = kp0 + (t & 3) * SLOT; const LAS unsigned char* kpn = kp0 + ((t + 1) & 3) * SLOT;
        const LAS unsigned char* vpc = vp0 + (t & 3) * SLOT;
        DMA_K(t + 3, ((t + 3) & 3) * SLOT); DMA_V(t + 3, ((t + 3) & 3) * SLOT);
        const bool near = (k0 > qw - 154) && (k0 < qw + 122);
        if (k0 >= qw + 122 && !in_hi) { in_hi = true; l0 *= hi_scale; l1 *= hi_scale; l0b *= hi_scale; l1b *= hi_scale;
            o00 = o00 * hi_scale; o01 = o01 * hi_scale; o10 = o10 * hi_scale; o11 = o11 * hi_scale; Y0 = Y0 * hi_scale; Y1 = Y1 * hi_scale; }
        SBAR();
        GAPA(X0 = ATT_MFMA(kfa[0], qr[0], zero16), Y0, 0, pw0, l1, l1b);
        GAPA(X1 = ATT_MFMA(kfa[1], qr[0], zero16), Y0, 8, pw1, l1, l1b);
        GAPA(X0 = ATT_MFMA(kfa[2], qr[1], X0), Y1, 0, pw2, l1, l1b);
        GAPA(X1 = ATT_MFMA(kfa[3], qr[1], X1), Y1, 8, pw3, l1, l1b);
        NEARADD(X0, X1); SBAR();
        GAPB(o10 = ATT_MFMA(PAF(0), VFR(0), o10), X0, 0);
        GAPB(o11 = ATT_MFMA(PAF(0), VFR(4), o11), X0, 4);
        KLD(kfb, kpc, 1, 0); SBAR(); GAPB(o10 = ATT_MFMA(PAF(1), VFR(1), o10), X0, 8);
        KLD(kfb, kpc, 1, 1); SBAR(); GAPB(o11 = ATT_MFMA(PAF(1), VFR(5), o11), X0, 12);
        KLD(kfb, kpc, 1, 2); SBAR(); GAPB(o10 = ATT_MFMA(PAF(2), VFR(2), o10), X1, 0);
        KLD(kfb, kpc, 1, 3); SBAR(); GAPB(o11 = ATT_MFMA(PAF(2), VFR(6), o11), X1, 4);
        GAPB(o10 = ATT_MFMA(PAF(3), VFR(3), o10), X1, 8);
        GAPB(o11 = ATT_MFMA(PAF(3), VFR(7), o11), X1, 12);
        VRD(0, vpc); VRD(4, vpc); SBAR(); GAPA(Y0 = ATT_MFMA(kfb[0], qr[2], zero16), X0, 0, pw0, l0, l0b);
        VRD(1, vpc); VRD(5, vpc); SBAR(); GAPA(Y1 = ATT_MFMA(kfb[1], qr[2], zero16), X0, 8, pw1, l0, l0b);
        VRD(2, vpc); VRD(6, vpc); SBAR(); GAPA(Y0 = ATT_MFMA(kfb[2], qr[3], Y0), X1, 0, pw2, l0, l0b);
        VRD(3, vpc); VRD(7, vpc); SBAR(); GAPA(Y1 = ATT_MFMA(kfb[3], qr[3], Y1), X1, 8, pw3, l0, l0b);
        NEARADD(Y0, Y1); SBAR();
        GAPB(o00 = ATT_MFMA(PAF(0), VFR(0), o00), Y0, 0);
        GAPB(o01 = ATT_MFMA(PAF(0), VFR(4), o01), Y0, 4);
        KLD(kfa, kpn, 0, 0); SBAR(); GAPB(o00 = ATT_MFMA(PAF(1), VFR(1), o00), Y0, 8);
        KLD(kfa, kpn, 0, 1); SBAR(); GAPB(o01 = ATT_MFMA(PAF(1), VFR(5), o01), Y0, 12);
        KLD(kfa, kpn, 0, 2); SBAR(); GAPB(o00 = ATT_MFMA(PAF(2), VFR(2), o00), Y1, 0);
        KLD(kfa, kpn, 0, 3); SBAR(); GAPB(o01 = ATT_MFMA(PAF(2), VFR(6), o01), Y1, 4);
        GAPB(o00 = ATT_MFMA(PAF(3), VFR(3), o00), Y1, 8);
        GAPB(o01 = ATT_MFMA(PAF(3), VFR(7), o01), Y1, 12);
        __builtin_amdgcn_s_waitcnt(0x0073); asm volatile("s_barrier" ::: "memory");
    }
    __builtin_amdgcn_s_setprio(0);
    if (tid == 0) nx();
    u32x4 gav[4];
    { const size_t grow = rowbase + qw + (lane >> 1); const bf16_t* ga = (const bf16_t*)(P.ws + WS_GA) + grow * 512 + h * 64 + (lane & 1) * 32;
#pragma unroll
      for (int j = 0; j < 4; ++j) gav[j] = *(const u32x4*)(ga + 8 * j); }
    { float sacc = l1, saccb = l1b;
#define DRAINW(PW, Pv, B) do { unsigned w0_ = pk2(Pv[B], Pv[B + 1]), w1_ = pk2(Pv[B + 2], Pv[B + 3]), w2_ = pk2(Pv[B + 4], Pv[B + 5]), w3_ = pk2(Pv[B + 6], Pv[B + 7]); \
        PIN(w0_); PIN(w1_); PIN(w2_); PIN(w3_); DOT1(sacc, w0_); DOT1(saccb, w1_); DOT1(sacc, w2_); DOT1(saccb, w3_); PW = (u32x4){w0_, w1_, w2_, w3_}; } while (0)
      DRAINW(pw0, Y0, 0); DRAINW(pw1, Y0, 8); DRAINW(pw2, Y1, 0); DRAINW(pw3, Y1, 8);
      l1 = sacc + saccb; l0 += l0b;
      o10 = ATT_MFMA(PAF(0), VFR(0), o10); o11 = ATT_MFMA(PAF(0), VFR(4), o11); o10 = ATT_MFMA(PAF(1), VFR(1), o10); o11 = ATT_MFMA(PAF(1), VFR(5), o11);
      o10 = ATT_MFMA(PAF(2), VFR(2), o10); o11 = ATT_MFMA(PAF(2), VFR(6), o11); o10 = ATT_MFMA(PAF(3), VFR(3), o10); o11 = ATT_MFMA(PAF(3), VFR(7), o11); }
    { auto r0 = __builtin_amdgcn_permlane32_swap(__float_as_uint(l0), __float_as_uint(l0), false, false); l0 = __uint_as_float(r0[0]) + __uint_as_float(r0[1]);
      auto r1 = __builtin_amdgcn_permlane32_swap(__float_as_uint(l1), __float_as_uint(l1), false, false); l1 = __uint_as_float(r1[0]) + __uint_as_float(r1[1]); }
    if (hi == 0) { wsf[r32] = 1.f / l0; wsf[32 + r32] = lam / l1; }
    asm volatile("s_waitcnt lgkmcnt(0)" ::: "memory");
#pragma unroll
    for (int r = 0; r < 16; ++r) { const int q = crow(r, hi); const float a0 = wsf[q], a1 = wsf[32 + q];
        stg[q * 64 + r32] = o00[r] * a0 - o10[r] * a1; stg[q * 64 + 32 + r32] = o01[r] * a0 - o11[r] * a1; }
    asm volatile("s_waitcnt lgkmcnt(0)" ::: "memory");
    { const int row = lane >> 1, hf = lane & 1; const LAS float* sr = stg + row * 64 + hf * 32; f32x4 v[8]; float ss = 0.f;
#pragma unroll
      for (int j = 0; j < 8; ++j) { v[j] = *(const LAS f32x4*)(sr + 4 * j); ss += (v[j][0]*v[j][0] + v[j][1]*v[j][1]) + (v[j][2]*v[j][2] + v[j][3]*v[j][3]); }
      ss += __shfl_xor(ss, 1);
      const float rs = rsqrtf(ss * (1.f / 64.f) + EPS) * (1.f - LAM_INIT);
      const size_t grow = rowbase + qw + row;
      bf16_t* mix = (bf16_t*)(P.ws + WS_MIX) + grow * DM + h * 64 + hf * 32;
      const float* sn = P.sub_norm + hf * 32;
#pragma unroll
      for (int j = 0; j < 4; ++j) { const u32x4 g = gav[j]; const f32x4 n0 = *(const f32x4*)(sn + 8 * j), n1 = *(const f32x4*)(sn + 8 * j + 4); const f32x4 a = v[2*j] * rs * n0, b = v[2*j+1] * rs * n1;
          u32x4 w; w.x = pk2(a[0] * bf2f(g.x & 0xffff), a[1] * bf2f(g.x >> 16)); w.y = pk2(a[2] * bf2f(g.y & 0xffff), a[3] * bf2f(g.y >> 16));
          w.z = pk2(b[0] * bf2f(g.z & 0xffff), b[1] * bf2f(g.z >> 16)); w.w = pk2(b[2] * bf2f(g.w & 0xffff), b[3] * bf2f(g.w >> 16));
          *(u32x4*)(mix + 8 * j) = w; }
    }
    WAIT_BAR(0);
#undef DMA_K
#undef DMA_V
}
}


namespace lru {
typedef short bf16x8 __attribute__((ext_vector_type(8)));
typedef float f32x16 __attribute__((ext_vector_type(16)));
constexpr int T = 64, YBS = 72;
constexpr int XS_OFF = 0, YB_OFF = 8704, HT_OFF = YB_OFF + 9216, AG_OFF = HT_OFF + 16384, DIR_BYTES = AG_OFF + 1024;
static_assert(2 * DIR_BYTES <= 131072, "LRU LDS");
template <int DIR> __device__ __forceinline__ void scan_pre(const float (&a)[16], const float (&b)[16], int hi, float (&Pin)[4], float (&Cin)[4], float& Ah, float& Hh) {
    float Ag[4], Hg[4], pA[4], pH[4];
#pragma unroll
    for (int g = 0; g < 4; ++g) { float A = 1.f, H = 0.f;
#pragma unroll
        for (int qq = 0; qq < 4; ++qq) { const int r = 4 * g + (DIR ? 3 - qq : qq); H = a[r] * H + b[r]; A *= a[r]; }
        Ag[g] = A; Hg[g] = H; pA[g] = __shfl_xor(A, 32); pH[g] = __shfl_xor(H, 32); }
    float Pc = 1.f, Cc = 0.f;
    const bool own_first = DIR ? (hi == 1) : (hi == 0);
#pragma unroll
    for (int s = 0; s < 4; ++s) { const int g = DIR ? 3 - s : s;
        const float A1 = own_first ? Ag[g] : pA[g], H1 = own_first ? Hg[g] : pH[g], A2 = own_first ? pA[g] : Ag[g], H2 = own_first ? pH[g] : Hg[g];
        const float C1 = A1 * Cc + H1, P1 = Pc * A1;
        Pin[g] = own_first ? Pc : P1; Cin[g] = own_first ? Cc : C1;
        Cc = A2 * C1 + H2; Pc = P1 * A2; }
    Ah = Pc; Hh = Cc;
}
template <int DIR> __device__ __forceinline__ void scan_post(const float (&a)[16], const float (&b)[16], const float (&Pin)[4], const float (&Cin)[4], float cin, float (&h)[16]) {
#pragma unroll
    for (int g = 0; g < 4; ++g) { float C = Pin[g] * cin + Cin[g];
#pragma unroll
        for (int qq = 0; qq < 4; ++qq) { const int r = 4 * g + (DIR ? 3 - qq : qq); C = a[r] * C + b[r]; h[r] = C; } }
}
__device__ __forceinline__ void lru_unit(LAS unsigned char* lds0, const Ptrs& P, const int sq, const int n, const Deq& nx) {
    int tid_ = threadIdx.x; asm volatile("" : "+v"(tid_));
    const int tid = tid_, lane = tid & 63, r32 = lane & 31, hi = lane >> 5; const int wid = __builtin_amdgcn_readfirstlane(tid >> 6);
    const int dir = wid >> 2, w4 = wid & 3, tid4 = tid & 255, tb = w4 & 1, cbk = w4 >> 1;
    const int S = sq < BP ? SP : SS; const size_t rowbase = sq < BP ? (size_t)sq * SP : (size_t)MP + (size_t)(sq - BP) * SS;
    LAS unsigned char* lds = lds0 + dir * DIR_BYTES;
    LAS bf16_t* xs = (LAS bf16_t*)(lds + XS_OFF); LAS bf16_t* yb = (LAS bf16_t*)(lds + YB_OFF); LAS float* ht = (LAS float*)(lds + HT_OFF); LAS float* agg = (LAS float*)(lds + AG_OFF);
    const int ch = cbk * 32 + r32, gch = n * 64 + ch;
    const bf16_t* XRb = (const bf16_t*)(P.ws + WS_XR) + rowbase * 512 + n * 64;
    const bf16_t* GLb = (const bf16_t*)(P.ws + WS_GL) + rowbase * 512 + n * 64;
    float* HSmine = (float*)(P.ws + (dir ? WS_HSB : WS_HSF)) + rowbase * 512 + n * 64; const float* HSoth = (const float*)(P.ws + (dir ? WS_HSF : WS_HSB)) + rowbase * 512 + n * 64;
    bf16_t* MIXb = (bf16_t*)(P.ws + WS_MIX) + rowbase * DM + 512 + n * 64;
    const float cw0 = P.conv_w[gch], cw1 = P.conv_w[512 + gch], cw2 = P.conv_w[1024 + gch], cw3 = P.conv_w[1536 + gch], cb = P.conv_b[gch];
    const float* Wa = P.w_a + (size_t)(dir * 8 + n) * 4096; const float* Wx = P.w_x + (size_t)(dir * 8 + n) * 4096;
    bf16x8 wfa[4], wfx[4];
#pragma unroll
    for (int ks = 0; ks < 4; ++ks)
#pragma unroll
        for (int j = 0; j < 8; ++j) { wfa[ks][j] = (short)f2bf(-LOG2E * Wa[(16 * ks + 8 * hi + j) * 64 + ch]); wfx[ks][j] = (short)f2bf(-LOG2E * Wx[(16 * ks + 8 * hi + j) * 64 + ch]); }
    const float ba = -LOG2E * P.b_a[dir * 512 + gch], bx = -LOG2E * P.b_x[dir * 512 + gch];
    f32x16 biasA, biasX;
#pragma unroll
    for (int r = 0; r < 16; ++r) { biasA[r] = ba; biasX[r] = bx; }
    const float lmb = P.lam[dir * 512 + gch];
    const float c8 = -8.f * LOG2E * (lmb > 15.f ? __expf(-lmb) : log1pf(__expf(-lmb)));
    const int NC = S / T;
    auto xload = [&](int c, u32x4& p0, u32x4& p1, u32x4& p2) {
        const int t0 = c * T; const u32x4 z = {0u, 0u, 0u, 0u};
        { const int r = tid4 >> 3, pc = tid4 & 7; const int t = t0 - 2 + r; p0 = (t >= 0 && t < S) ? *(const u32x4*)(XRb + (size_t)t * 512 + pc * 8) : z; }
        { const int r = 32 + (tid4 >> 3), pc = tid4 & 7; const int t = t0 - 2 + r; p1 = (t >= 0 && t < S) ? *(const u32x4*)(XRb + (size_t)t * 512 + pc * 8) : z; }
        { const int r = 64 + (tid4 >> 3), pc = tid4 & 7; const int t = t0 - 2 + r; p2 = (tid4 < 24 && t >= 0 && t < S) ? *(const u32x4*)(XRb + (size_t)t * 512 + pc * 8) : z; }
    };
    u32x4 xp0, xp1, xp2; xload(dir ? NC - 1 : 0, xp0, xp1, xp2);
    float car = 0.f;
    const bool first = dir ? (tb == 1) : (tb == 0);
    __syncthreads();
    for (int i = 0; i < NC; ++i) {
        const int c = dir ? NC - 1 - i : i, t0 = c * T; const bool comb = i >= NC / 2;
        if (i == NC - 1 && tid == 0) nx();
        { const int r = tid4 >> 3, pc = tid4 & 7; *(LAS u32x4*)(xs + r * 64 + pc * 8) = xp0; *(LAS u32x4*)(xs + (32 + r) * 64 + pc * 8) = xp1; if (tid4 < 24) *(LAS u32x4*)(xs + (64 + r) * 64 + pc * 8) = xp2; }
        asm volatile("s_waitcnt vmcnt(0)" ::: "memory");
        __syncthreads();
        if (i + 1 < NC) xload(dir ? NC - 2 - i : i + 1, xp0, xp1, xp2);
        f32x4 oth[4]; uint2 glv[4];
#pragma unroll
        for (int k = 0; k < 4; ++k) { const int idx = tid4 + 256 * k, row = idx >> 4, c4 = idx & 15; const size_t off = (size_t)(t0 + row) * 512 + c4 * 4;
            if (comb) { oth[k] = *(const f32x4*)(HSoth + off); glv[k] = *(const uint2*)(GLb + off); } else { oth[k] = (f32x4){0.f, 0.f, 0.f, 0.f}; glv[k] = make_uint2(0u, 0u); } }
        float y[16];
#pragma unroll
        for (int g = 0; g < 4; ++g) { const int base = 32 * tb + 8 * g + 4 * hi; float xv[7];
#pragma unroll
            for (int j = 0; j < 7; ++j) xv[j] = bf2f(xs[(base + j) * 64 + ch]);
#pragma unroll
            for (int q = 0; q < 4; ++q) { const float yy = cb + cw0 * xv[q] + cw1 * xv[q + 1] + cw2 * xv[q + 2] + cw3 * xv[q + 3]; y[4 * g + q] = yy; yb[(base + q) * YBS + ch] = (bf16_t)(pk2(yy, 0.f) & 0xffffu); } }
        __syncthreads();
        f32x16 acca, accx;
#pragma unroll
        for (int ks = 0; ks < 4; ++ks) { const bf16x8 af = *(const LAS bf16x8*)(yb + (tb * 32 + r32) * YBS + 16 * ks + 8 * hi);
            acca = __builtin_amdgcn_mfma_f32_32x32x16_bf16(af, wfa[ks], ks == 0 ? biasA : acca, 0, 0, 0); accx = __builtin_amdgcn_mfma_f32_32x32x16_bf16(af, wfx[ks], ks == 0 ? biasX : accx, 0, 0, 0); }
        float a[16], b[16];
#pragma unroll
        for (int r = 0; r < 16; ++r) { const float rg = __builtin_amdgcn_rcpf(1.f + __builtin_amdgcn_exp2f(acca[r])), ig = __builtin_amdgcn_rcpf(1.f + __builtin_amdgcn_exp2f(accx[r]));
            const float av = __builtin_amdgcn_exp2f(c8 * rg); a[r] = av; b[r] = __builtin_amdgcn_sqrtf(fmaxf(1.f - av * av, 0.f)) * ig * y[r]; }
        float Pin[4] = {1.f, 1.f, 1.f, 1.f}, Cin[4] = {0.f, 0.f, 0.f, 0.f}, Ah, Hh;
        if (dir == 0) scan_pre<0>(a, b, hi, Pin, Cin, Ah, Hh); else scan_pre<1>(a, b, hi, Pin, Cin, Ah, Hh);
        if (hi == 0) { agg[(tb * 64 + ch) * 2] = Ah; agg[(tb * 64 + ch) * 2 + 1] = Hh; }
        __syncthreads();
        const float Ao = agg[((tb ^ 1) * 64 + ch) * 2], Ho = agg[((tb ^ 1) * 64 + ch) * 2 + 1];
        const float cin = first ? car : Ao * car + Ho;
        car = first ? Ao * (Ah * car + Hh) + Ho : Ah * cin + Hh;
        float h[16];
        if (dir == 0) scan_post<0>(a, b, Pin, Cin, cin, h); else scan_post<1>(a, b, Pin, Cin, cin, h);
#pragma unroll
        for (int r = 0; r < 16; ++r) ht[(32 * tb + ((r & 3) + 8 * (r >> 2) + 4 * hi)) * 64 + ch] = h[r];
        __syncthreads();
#pragma unroll
        for (int k = 0; k < 4; ++k) { const int idx = tid4 + 256 * k, row = idx >> 4, c4 = idx & 15; const size_t off = (size_t)(t0 + row) * 512 + c4 * 4;
            const f32x4 h4 = *(const LAS f32x4*)(ht + row * 64 + c4 * 4);
            if (!comb) *(f32x4*)(HSmine + off) = h4;
            else { const f32x4 sm = h4 + oth[k]; uint2 o; o.x = pk2(sm[0] * bf2f(glv[k].x & 0xffff), sm[1] * bf2f(glv[k].x >> 16)); o.y = pk2(sm[2] * bf2f(glv[k].y & 0xffff), sm[3] * bf2f(glv[k].y >> 16));
                   *(uint2*)(MIXb + (size_t)(t0 + row) * DM + c4 * 4) = o; } }
    }
}
}

typedef __attribute__((address_space(1))) unsigned gu32;
#define XB_TMO      128
#define XB_XCNT(j)  (256  + 64 * (j))
#define XB_XSUB(j)  (1280 + 64 * (j))
#define XB_XGEN(j)  (2304 + 64 * (j))
#define XB_TOP      3328
#define XB_TOPGEN   3392
#define XCD_BAR_WORDS 3456
#define XB_SPIN_CAP (1u << 18)

__device__ __forceinline__ unsigned xb_ld(unsigned* p)              { return __hip_atomic_load(p, __ATOMIC_RELAXED, __HIP_MEMORY_SCOPE_AGENT); }
__device__ __forceinline__ unsigned xb_add(unsigned* p, unsigned v) { return __hip_atomic_fetch_add(p, v, __ATOMIC_RELAXED, __HIP_MEMORY_SCOPE_AGENT); }
__device__ __forceinline__ unsigned xb_xcc_id() { return (unsigned)__builtin_amdgcn_s_getreg((3 << 11) | 20) & 0xFu; }
#define XB_SPIN(cond, bar) do { unsigned _sp = 0; while (cond) { __builtin_amdgcn_s_sleep(1); \
    if ((++_sp & 255u) == 0u) { if (xb_ld(&(bar)[XB_TMO])) break; if (_sp > XB_SPIN_CAP) { atomicAdd(&(bar)[XB_TMO], 1u); break; } } } } while (0)

struct XcdBarrier {
    unsigned* bar; unsigned x;
    volatile LAS unsigned* st;
};

__device__ __forceinline__ XcdBarrier xcd_barrier_post(unsigned* bar, volatile LAS unsigned* st) {
    XcdBarrier b; b.bar = bar; b.x = xb_xcc_id(); b.st = st;
    if (threadIdx.x == 0) (void)xb_add(&bar[XB_XCNT(b.x)], 1u);
    return b;
}
__device__ __forceinline__ void xcd_barrier_complete(unsigned* bar, unsigned x, unsigned& nloc, unsigned& nx) {
    const unsigned G = gridDim.x * gridDim.y * gridDim.z;
    unsigned sum, cnt, mine, sp = 0u;
    for (;;) {
        sum = 0u; cnt = 0u; mine = 0u;
#pragma unroll
        for (unsigned j = 0; j < 16; ++j) { const unsigned c = xb_ld(&bar[XB_XCNT(j)]); sum += c; cnt += (c > 0u) ? 1u : 0u; mine = (j == x) ? c : mine; }
        if (sum == G) break;
        __builtin_amdgcn_s_sleep(1);
        if ((++sp & 255u) == 0u) { if (xb_ld(&bar[XB_TMO])) break; if (sp > XB_SPIN_CAP) { atomicAdd(&bar[XB_TMO], 1u); break; } }
    }
    nloc = mine > 0u ? mine : 1u; nx = cnt > 0u ? cnt : 1u;
}

__device__ __forceinline__ void xcd_barrier(const XcdBarrier& b) {
    asm volatile("s_waitcnt vmcnt(0)" ::: "memory");
    __syncthreads();
    if (threadIdx.x == 0) {
        unsigned* bar = b.bar;
        __builtin_amdgcn_s_waitcnt(0);
        unsigned nloc = b.st[0], nx = b.st[1];
        if (nloc == 0u) { xcd_barrier_complete(bar, b.x, nloc, nx); b.st[0] = nloc; b.st[1] = nx; }
        const unsigned old = xb_add(&bar[XB_XSUB(b.x)], 1u);
        const unsigned gen = old / nloc;
        if (old + 1u == (gen + 1u) * nloc) {
            __builtin_amdgcn_fence(__ATOMIC_RELEASE, "agent");
            asm volatile("s_waitcnt vmcnt(0)" ::: "memory");
            const unsigned og = xb_add(&bar[XB_TOP], 1u);
            const unsigned tg = og / nx;
            if (og + 1u == (tg + 1u) * nx) xb_add(&bar[XB_TOPGEN], 1u);
            else XB_SPIN(xb_ld(&bar[XB_TOPGEN]) == tg, bar);
            __builtin_amdgcn_fence(__ATOMIC_ACQUIRE, "agent");
            xb_add(&bar[XB_XGEN(b.x)], 1u);
            asm volatile("s_waitcnt vmcnt(0)" ::: "memory");
        } else {
            XB_SPIN(xb_ld(&bar[XB_XGEN(b.x)]) == gen, bar);
            __builtin_amdgcn_fence(__ATOMIC_ACQUIRE, "agent");
            asm volatile("s_waitcnt vmcnt(0)" ::: "memory");
        }
    }
    __syncthreads();
}

struct Args { Ptrs P; int ph_lo, ph_hi; };
__global__ void __launch_bounds__(NTHREADS, 2) mk_fwd(Args a) {
    extern __shared__ __attribute__((aligned(16))) unsigned char lds_raw[];
    LAS unsigned char* lds = (LAS unsigned char*)lds_raw;
    const Ptrs& P = a.P; unsigned char* ws = P.ws;
    const int tid = threadIdx.x, lane = tid & 63, wave = __builtin_amdgcn_readfirstlane(tid >> 6);
    const int lo = a.ph_lo, hi = a.ph_hi;
#define IN(k) (lo <= (k) && (k) < hi)
#define BOTH(k) (IN(k) && IN((k) + 1))
    volatile LAS unsigned* MISC = (volatile LAS unsigned*)(lds + MISC_OFF);
    if (tid < 64) MISC[tid] = 0u;
    __syncthreads();
    XcdBarrier bar; bar.bar = (unsigned*)(ws + WS_CTL) + CW_BAR; bar.x = 0; bar.st = nullptr;
    if (hi - lo > 1) bar = xcd_barrier_post((unsigned*)(ws + WS_CTL) + CW_BAR, MISC + 8);
#define GRID_BAR() xcd_barrier(bar)
    if (IN(0)) { p0_prep(P, lds, wave, lane); if (BOTH(0)) GRID_BAR(); }
    if (IN(1)) { pg8::Gemm g{(const bf16_t*)(ws + WS_XN), (const bf16_t*)(ws + WS_WIN), MT, INC, 1024}; InProjOrder S; S.init(MT, INC, gridDim.x, blockIdx.x);
        S.P = &P; S.cnt = (unsigned*)(ws + WS_CTL) + CW_PREP; S.wave = wave; S.lane = lane; S.xcd = (int)(blockIdx.x & 7u); S.slot = (int)(blockIdx.x >> 3); S.ready_gid = -1;
        EpiIn E{ws, P.q_norm, P.k_norm}; pg8::gemm_phase<EpiIn, InProjOrder, true, true>(lds, g, S, E); if (BOTH(1)) GRID_BAR(); }
    if (IN(2)) {
        const float lam = *(const float*)(ws + WS_MISC);
        const Deq nx{(unsigned*)(ws + WS_CTL) + CW_QUEUE, xb_xcc_id() & 7u, MISC};
        if (tid == 0) { MISC[17] = 0u; nx(); }
        __syncthreads();
        for (;;) {
            const int item = (int)MISC[16];
            if (item < 0) break;
            const int x = item >> 10, j = item & 1023;
            if (j >= 344) { pb_item(P, x * 40 + (j - 344), wave, lane); if (tid == 0) nx(); }
            else if (j < 24) { const int sq = j < 16 ? x * 2 + (j >> 3) : 16 + x, nb = j < 16 ? (j & 7) : j - 16; lru::lru_unit(lds, P, sq, nb, nx); }
            else { const bool pr = j < 280; const int j2 = pr ? j - 24 : j - 280; const int bh = pr ? x * 16 + (j2 >> 4) : x * 8 + (j2 >> 3);
                   att::attn_unit(lds, P, lam, pr ? SP : SS, pr ? (size_t)(bh >> 3) * SP : (size_t)MP + (size_t)(bh >> 3) * SS, bh & 7, pr ? (j2 & 15) : (j2 & 7), nx); }
            __syncthreads();
        }
        if (IN(3)) {
            PleOrder S; S.q = (unsigned*)(ws + WS_CTL) + CW_PLEQ; S.pbc = (unsigned*)(ws + WS_CTL) + CW_PB; S.slots = MISC + 48; S.tid = tid; S.pend = 0u; S.ready_pm = -1;
            if (tid == 0) { MISC[48] = __hip_atomic_fetch_add(S.q, 1u, __ATOMIC_RELAXED, __HIP_MEMORY_SCOPE_AGENT); S.pend = __hip_atomic_fetch_add(S.q, 1u, __ATOMIC_RELAXED, __HIP_MEMORY_SCOPE_AGENT); }
            __syncthreads();
            pg8::Gemm g{(const bf16_t*)(ws + WS_PB), (const bf16_t*)(ws + WS_WPLE), MT, DM, 256}; EpiStore E{(bf16_t*)(ws + WS_PW)}; pg8::gemm_phase<EpiStore, PleOrder, true, true>(lds, g, S, E); }
        if (BOTH(2)) GRID_BAR(); }
    if (IN(4)) {
        pg8::Gemm g{(const bf16_t*)(ws + WS_MIX), (const bf16_t*)(ws + WS_WOUT), MT, DM, 1024}; pg8::StaticOrder S; S.init(MT, DM, gridDim.x, blockIdx.x);
        EpiOut E{P.xp, P.xs, P.out, (bf16_t*)(ws + WS_HB)}; pg8::gemm_phase<EpiOut, pg8::StaticOrder, true, true>(lds, g, S, E);
        if (BOTH(4)) GRID_BAR(); }
    if (IN(5)) {
        pg8::Gemm g{(const bf16_t*)(ws + WS_HB), (const bf16_t*)(ws + WS_WPG), MT, DM, 1024}; pg8::StaticOrder S; S.init(MT, DM, gridDim.x, blockIdx.x);
        EpiGateFinal E{(const bf16_t*)(ws + WS_PW), (const bf16_t*)(ws + WS_HB), P.out, P.g_ple, (float*)(ws + WS_HSF), (unsigned*)(ws + WS_CTL) + CW_PANEL}; pg8::gemm_phase<EpiGateFinal, pg8::StaticOrder, true, true>(lds, g, S, E); }
#undef IN
#undef BOTH
#undef GRID_BAR
}
extern "C" void kernel_launch(void* const* d_in, const int* in_sizes, int n_in, void* d_out, int out_size, void* d_ws, size_t ws_size, hipStream_t stream) {
    static int grid = 0;
    if (grid == 0) {
        if (n_in != 25 || out_size != MT * DM || ws_size < WS_END) { fprintf(stderr, "kernel_launch: unexpected shapes n_in %d out %d ws %zu\n", n_in, out_size, ws_size); grid = -1; return; }
        int dev = 0, cus = 0;
        if (hipGetDevice(&dev) != hipSuccess || hipDeviceGetAttribute(&cus, hipDeviceAttributeMultiprocessorCount, dev) != hipSuccess) { grid = -1; return; }
        if (hipFuncSetAttribute((const void*)mk_fwd, hipFuncAttributeMaxDynamicSharedMemorySize, LDS_BYTES) != hipSuccess) { fprintf(stderr, "kernel_launch: hipFuncSetAttribute failed\n"); grid = -1; return; }
        if (cus != 256) { fprintf(stderr, "kernel_launch: the row-group ownership of the prep assumes 256 CUs, found %d\n", cus); grid = -1; return; }
        grid = cus;
    }
    if (grid < 0) return;
    Args a{};
    const float** f = (const float**)&a.P;
    for (int i = 0; i < 25; ++i) f[i] = (const float*)d_in[i];
    a.P.out = (float*)d_out; a.P.ws = (unsigned char*)d_ws;
    hipMemsetAsync((char*)d_ws + WS_CTL, 0, CTL_ZERO_BYTES, stream);
    auto run = [&](int lo, int hi) { a.ph_lo = lo; a.ph_hi = hi; hipLaunchKernelGGL(mk_fwd, dim3(grid), dim3(NTHREADS), LDS_BYTES, stream, a); };
    run(0, 6);
}
```
